# Optimizing an MI355X kernel written in HIP

```python
import math
import jax
import jax.numpy as jnp
from jax import lax
import numpy as np

D_MODEL = 1024
BATCH = 8
SEQ = 8192
DEPTH = 2

CTX_LEN = 256
GRID_W = 64
N_HEADS = 8
N_KV_HEADS = 2
KV_GROUP = N_HEADS // N_KV_HEADS
HEAD_DIM = 128
ATTN_WIDTH = N_HEADS * HEAD_DIM
KV_WIDTH = N_KV_HEADS * HEAD_DIM
ROPE_AXIS_DIM = HEAD_DIM // 2
ROPE_THETA = 10000.0
Q_BLOCK = 128
HYENA_WIDTH = D_MODEL // 2
HYENA_PROJ = 3 * HYENA_WIDTH
SHORT_CONV = 3
FILTER_EMB = 33
FILTER_BANDS = (FILTER_EMB - 1) // 2
FILTER_HIDDEN = 64
FILTER_OUT_GAIN = 0.05
DECAY_TARGET = 1e-2
FAST_DECAY_PCT = 0.3
SLOW_DECAY_PCT = 1.5
N_BRANCHES = 2
GATE_WIDTH = N_BRANCHES * D_MODEL
PROJ_WIDTH = ATTN_WIDTH + 2 * KV_WIDTH + HYENA_PROJ + GATE_WIDTH
PROJ_SPLITS = (ATTN_WIDTH, ATTN_WIDTH + KV_WIDTH, ATTN_WIDTH + 2 * KV_WIDTH,
               ATTN_WIDTH + 2 * KV_WIDTH + HYENA_PROJ)
D_FF = (8 * D_MODEL + 3 * 256 - 1) // (3 * 256) * 256
N_MOD = 6
EPS = 1e-6

kernel_name = 'hybrid_gqa_hyena_diffusion_block'


def rms_norm(x, gain):
    xf = x.astype(jnp.float32)
    y = xf * lax.rsqrt(jnp.mean(xf * xf, axis=-1, keepdims=True) + EPS)
    return (y * gain.astype(jnp.float32)).astype(x.dtype)


def modulate(h, shift, scale):
    return h * (1 + scale) + shift


def split_heads_norm(t, gain, n_heads):
    t = t.reshape(t.shape[0], t.shape[1], n_heads, HEAD_DIM)
    return rms_norm(t, gain)


def axial_rope_tables(rows):
    row = jnp.repeat(jnp.arange(rows, dtype=jnp.float32), GRID_W)
    col = jnp.tile(jnp.arange(GRID_W, dtype=jnp.float32), rows)
    inv_freq = ROPE_THETA ** (-jnp.arange(0, ROPE_AXIS_DIM, 2, dtype=jnp.float32) / ROPE_AXIS_DIM)
    ang = jnp.concatenate([row[:, None] * inv_freq, col[:, None] * inv_freq], axis=-1)
    return jnp.cos(ang), jnp.sin(ang)


def apply_rope(t, cos, sin):
    tf = t.astype(jnp.float32).reshape(*t.shape[:-1], HEAD_DIM // 2, 2)
    c = cos[None, :, None, :]
    s = sin[None, :, None, :]
    t0, t1 = tf[..., 0], tf[..., 1]
    out = jnp.stack([t0 * c - t1 * s, t0 * s + t1 * c], axis=-1)
    return out.reshape(t.shape).astype(t.dtype)


def latent_attention(q, k, v, k_ctx, v_ctx):
    b, length = q.shape[0], q.shape[1]
    n_blocks = length // Q_BLOCK
    keys = jnp.concatenate([k_ctx, k], axis=1)
    vals = jnp.concatenate([v_ctx, v], axis=1)
    qb = q.reshape(b, n_blocks, Q_BLOCK, N_KV_HEADS, KV_GROUP, HEAD_DIM)
    qb = jnp.moveaxis(qb, 1, 0)
    scale = HEAD_DIM ** -0.5

    def one_block(q_blk):
        s = jnp.einsum('bqhgd,bkhd->bhgqk', q_blk, keys, preferred_element_type=jnp.float32) * scale
        p = jax.nn.softmax(s, axis=-1).astype(vals.dtype)
        return jnp.einsum('bhgqk,bkhd->bqhgd', p, vals)

    out = lax.map(one_block, qb)
    return jnp.moveaxis(out, 0, 1).reshape(b, length, ATTN_WIDTH)


def context_attention(q, k, v):
    b, length = q.shape[0], q.shape[1]
    qg = q.reshape(b, length, N_KV_HEADS, KV_GROUP, HEAD_DIM)
    s = jnp.einsum('bqhgd,bkhd->bhgqk', qg, k, preferred_element_type=jnp.float32) * HEAD_DIM ** -0.5
    p = jax.nn.softmax(s, axis=-1).astype(v.dtype)
    return jnp.einsum('bhgqk,bkhd->bqhgd', p, v).reshape(b, length, ATTN_WIDTH)


def short_conv(u, w, bias):
    up = jnp.pad(u, ((0, 0), (1, 1), (0, 0)))
    return up[:, :-2] * w[0] + up[:, 1:-1] * w[1] + up[:, 2:] * w[2] + bias


def hyena_filter(length, fw1, fb1, fw2, fb2, fw3, fb3, fw4, freq):
    t = jnp.linspace(0.0, 1.0, length, dtype=jnp.float32)[:, None]
    w = (2.0 * math.pi / length) * jnp.arange(length, dtype=jnp.float32)[:, None]
    f = jnp.linspace(1e-4, FILTER_BANDS - 1, FILTER_BANDS, dtype=jnp.float32)[None, :]
    z = jnp.concatenate([t, jnp.cos(f * w), -jnp.sin(f * w)], axis=-1)
    h = jnp.sin(freq[0] * (z @ fw1 + fb1))
    h = jnp.sin(freq[1] * (h @ fw2 + fb2))
    h = jnp.sin(freq[2] * (h @ fw3 + fb3))
    h = (h @ fw4).reshape(length, 2, HYENA_WIDTH)
    max_decay = math.log(DECAY_TARGET) / FAST_DECAY_PCT
    min_decay = math.log(DECAY_TARGET) / SLOW_DECAY_PCT
    deltas = jnp.abs(jnp.linspace(min_decay, max_decay, HYENA_WIDTH, dtype=jnp.float32))
    decay = jnp.exp(-t * deltas)
    h = h * decay[:, None, :]
    return h[:, 0], h[:, 1]


def bidirectional_long_conv(v, h_fwd, h_bwd):
    length = v.shape[1]
    n_fft = 2 * length
    k = jnp.concatenate([h_fwd, jnp.zeros((1, HYENA_WIDTH), h_fwd.dtype), h_bwd[:0:-1]], axis=0)
    v_f = jnp.fft.rfft(v.astype(jnp.float32), n=n_fft, axis=1)
    k_f = jnp.fft.rfft(k, n=n_fft, axis=0)
    return jnp.fft.irfft(v_f * k_f[None], n=n_fft, axis=1)[:, :length]


def hyena_mix(u, conv_w, conv_b, fw1, fb1, fw2, fb2, fw3, fb3, fw4, freq, bias):
    length = u.shape[1]
    x0, x1, v = jnp.split(short_conv(u, conv_w, conv_b), 3, axis=-1)
    v = v * x1
    h_fwd, h_bwd = hyena_filter(length, fw1, fb1, fw2, fb2, fw3, fb3, fw4, freq)
    y = bidirectional_long_conv(v, h_fwd, h_bwd) + v.astype(jnp.float32) * bias
    return (y * x0).astype(u.dtype)


def merge_branches(attn_out, hyena_out, gate_logits, w_o_attn, w_o_hyena, w_out):
    g_attn, g_hyena = jnp.split(jax.nn.sigmoid(gate_logits), N_BRANCHES, axis=-1)
    merged = g_attn * (attn_out @ w_o_attn) + g_hyena * (hyena_out @ w_o_hyena)
    return merged @ w_out


def swiglu(h, w_gate_up, w_down):
    g, u = jnp.split(h @ w_gate_up, 2, axis=-1)
    return (jax.nn.silu(g) * u) @ w_down


def setup_inputs(seed: int = 0) -> dict:
    key = jax.random.key(seed)
    ks = jax.random.split(key, 28)
    D = D_MODEL

    def nrm(k, shape, scale=1.0):
        return jax.random.normal(k, shape, jnp.float32) * scale

    return {
        'x': nrm(ks[0], (BATCH, SEQ, D)),
        'c': nrm(ks[1], (BATCH, D)),
        'ctx': nrm(ks[2], (BATCH, CTX_LEN, D)),
        'c_ctx': nrm(ks[3], (D,)),
        'w_mod': nrm(ks[4], (DEPTH, D, N_MOD * D), D ** -0.5),
        'b_mod': nrm(ks[5], (DEPTH, N_MOD * D), 0.01),
        'norm_mix': 1.0 + nrm(ks[6], (DEPTH, D), 0.05),
        'w_in': nrm(ks[7], (DEPTH, D, PROJ_WIDTH), D ** -0.5),
        'q_norm': 1.0 + nrm(ks[8], (DEPTH, HEAD_DIM), 0.05),
        'k_norm': 1.0 + nrm(ks[9], (DEPTH, HEAD_DIM), 0.05),
        'conv_w': nrm(ks[10], (DEPTH, SHORT_CONV, HYENA_PROJ), SHORT_CONV ** -0.5),
        'conv_b': nrm(ks[11], (DEPTH, HYENA_PROJ), 0.01),
        'filt_w1': nrm(ks[12], (DEPTH, FILTER_EMB, FILTER_HIDDEN), FILTER_EMB ** -0.5),
        'filt_b1': nrm(ks[13], (DEPTH, FILTER_HIDDEN), 0.1),
        'filt_w2': nrm(ks[14], (DEPTH, FILTER_HIDDEN, FILTER_HIDDEN), FILTER_HIDDEN ** -0.5),
        'filt_b2': nrm(ks[15], (DEPTH, FILTER_HIDDEN), 0.1),
        'filt_w3': nrm(ks[16], (DEPTH, FILTER_HIDDEN, FILTER_HIDDEN), FILTER_HIDDEN ** -0.5),
        'filt_b3': nrm(ks[17], (DEPTH, FILTER_HIDDEN), 0.1),
        'filt_w4': nrm(ks[18], (DEPTH, FILTER_HIDDEN, 2 * HYENA_WIDTH), FILTER_HIDDEN ** -0.5 * FILTER_OUT_GAIN),
        'filt_freq': 1.0 + nrm(ks[19], (DEPTH, 3, FILTER_HIDDEN), 0.1),
        'hyena_bias': nrm(ks[20], (DEPTH, HYENA_WIDTH), 0.5),
        'w_o_attn': nrm(ks[21], (DEPTH, ATTN_WIDTH, D), ATTN_WIDTH ** -0.5),
        'w_o_hyena': nrm(ks[22], (DEPTH, HYENA_WIDTH, D), HYENA_WIDTH ** -0.5),
        'w_out': nrm(ks[23], (DEPTH, D, D), D ** -0.5),
        'norm_ffn': 1.0 + nrm(ks[24], (DEPTH, D), 0.05),
        'w_gate_up': nrm(ks[25], (DEPTH, D, 2 * D_FF), D ** -0.5),
        'w_down': nrm(ks[26], (DEPTH, D_FF, D), D_FF ** -0.5),
        'norm_final': 1.0 + nrm(ks[27], (D,), 0.05),
    }


def reference(x, c, ctx, c_ctx, w_mod, b_mod, norm_mix, w_in, q_norm, k_norm, conv_w, conv_b,
              filt_w1, filt_b1, filt_w2, filt_b2, filt_w3, filt_b3, filt_w4, filt_freq, hyena_bias,
              w_o_attn, w_o_hyena, w_out, norm_ffn, w_gate_up, w_down, norm_final):
    b, length = x.shape[0], x.shape[1]
    rows = length // GRID_W
    cos, sin = axial_rope_tables(rows)
    silu_c = jax.nn.silu(c)
    silu_cc = jax.nn.silu(c_ctx)
    for layer in range(DEPTH):
        last = layer == DEPTH - 1
        mod = (silu_c @ w_mod[layer] + b_mod[layer])[:, None, :]
        mod_c = silu_cc @ w_mod[layer] + b_mod[layer]
        shift1, scale1, gate1, shift2, scale2, gate2 = jnp.split(mod, N_MOD, axis=-1)
        c_shift1, c_scale1, c_gate1, c_shift2, c_scale2, c_gate2 = jnp.split(mod_c, N_MOD, axis=-1)
        filt = (filt_w1[layer], filt_b1[layer], filt_w2[layer], filt_b2[layer],
                filt_w3[layer], filt_b3[layer], filt_w4[layer], filt_freq[layer])

        h_ctx = modulate(rms_norm(ctx, norm_mix[layer]), c_shift1, c_scale1)
        if last:
            kc, vc = jnp.split(h_ctx @ w_in[layer][:, ATTN_WIDTH:ATTN_WIDTH + 2 * KV_WIDTH], 2, axis=-1)
        else:
            qc, kc, vc, hyc, gc = jnp.split(h_ctx @ w_in[layer], PROJ_SPLITS, axis=-1)
        kc = split_heads_norm(kc, k_norm[layer], N_KV_HEADS)
        vc = vc.reshape(b, vc.shape[1], N_KV_HEADS, HEAD_DIM)

        h = modulate(rms_norm(x, norm_mix[layer]), shift1, scale1)
        q, k, v, hy, g = jnp.split(h @ w_in[layer], PROJ_SPLITS, axis=-1)
        q = apply_rope(split_heads_norm(q, q_norm[layer], N_HEADS), cos, sin)
        k = apply_rope(split_heads_norm(k, k_norm[layer], N_KV_HEADS), cos, sin)
        v = v.reshape(b, length, N_KV_HEADS, HEAD_DIM)
        attn = latent_attention(q, k, v, kc, vc)
        hyo = hyena_mix(hy, conv_w[layer], conv_b[layer], *filt, hyena_bias[layer])
        x_mix = merge_branches(attn, hyo, g, w_o_attn[layer], w_o_hyena[layer], w_out[layer])

        if not last:
            attn_c = context_attention(split_heads_norm(qc, q_norm[layer], N_HEADS), kc, vc)
            hyo_c = hyena_mix(hyc, conv_w[layer], conv_b[layer], *filt, hyena_bias[layer])
            ctx_mix = merge_branches(attn_c, hyo_c, gc, w_o_attn[layer], w_o_hyena[layer], w_out[layer])
            ctx = ctx + c_gate1 * ctx_mix
            ctx = ctx + c_gate2 * swiglu(modulate(rms_norm(ctx, norm_ffn[layer]), c_shift2, c_scale2),
                                         w_gate_up[layer], w_down[layer])

        x = x + gate1 * x_mix
        x = x + gate2 * swiglu(modulate(rms_norm(x, norm_ffn[layer]), shift2, scale2),
                               w_gate_up[layer], w_down[layer])
    return rms_norm(x, norm_final)
```

```cpp
#include <hip/hip_runtime.h>
#include <hip/hip_bf16.h>
#include <hip/hip_cooperative_groups.h>
#include <cstdio>
#include <cstdint>
namespace cg = cooperative_groups;

constexpr int DM = 1024, NB = 8, SEQ = 8192, CTXL = 256, DEPTH = 2;
constexpr int MLAT = NB * SEQ, MCTX = NB * CTXL, MALL = MLAT + MCTX;
constexpr int PROJ = 5120, DFF = 2816, HYW = 512, HYP = 1536, GATEW = 2048, NMODV = 6 * DM;
constexpr int KEYS = CTXL + SEQ;
constexpr int NFFT = 16384;
constexpr float EPS = 1e-6f;
constexpr size_t MiB = 1u << 20;
constexpr size_t WS_MOD = 0;
constexpr size_t WS_TW = 512 * 1024;
constexpr size_t WS_ROPE = 1 * MiB;
constexpr size_t WS_W = 6 * MiB;
constexpr size_t WL_IN = 0, WL_OA = WL_IN + (size_t)PROJ * DM * 2, WL_OH = WL_OA + (size_t)DM * DM * 2, WL_OUT = WL_OH + (size_t)DM * HYW * 2,
                 WL_GU = WL_OUT + (size_t)DM * DM * 2, WL_DN = WL_GU + (size_t)2 * DFF * DM * 2, WL_STRIDE = WL_DN + (size_t)DM * DFF * 2;
constexpr size_t WS_KF = 70 * MiB;
constexpr size_t WS_H = 134 * MiB;
constexpr size_t WS_Q = 266 * MiB;
constexpr size_t WS_K = 398 * MiB;
constexpr size_t WS_V = 431 * MiB;
constexpr size_t WS_HYO = 398 * MiB;
constexpr size_t WS_HY = 464 * MiB;
constexpr size_t WS_G = 662 * MiB;
constexpr size_t WS_XS = 670 * MiB;
constexpr size_t WS_ACT = 266 * MiB;
constexpr size_t WS_CTXS = 926 * MiB;
constexpr size_t WS_FILT = 934 * MiB;
constexpr size_t WS_FILTC = 998 * MiB;
constexpr size_t WS_END = 1000 * MiB;
static_assert(WS_W + 2 * WL_STRIDE <= WS_KF && WS_H + (size_t)MALL * DM * 2 <= WS_Q && WS_Q + (size_t)MALL * DM * 2 <= WS_K && WS_K + (size_t)NB * KEYS * 256 * 2 <= WS_V &&
              WS_V + (size_t)NB * KEYS * 256 * 2 <= WS_HY && WS_HYO + (size_t)MALL * HYW * 2 <= WS_HY && WS_HY + (size_t)MALL * HYP * 2 <= WS_G && WS_G + (size_t)MCTX * GATEW * 2 <= WS_XS && WS_XS + (size_t)MALL * DM * 2 <= WS_CTXS && (size_t)MLAT * GATEW * 2 <= (size_t)MLAT * DM * 4 &&
              WS_ACT + (size_t)MALL * DFF * 2 <= WS_G && (size_t)HYW * NB * SEQ * 4 <= (size_t)MALL * DM * 2, "ws map");

#define LAS __attribute__((address_space(3)))
typedef float f32x4 __attribute__((ext_vector_type(4)));
typedef float f32x2 __attribute__((ext_vector_type(2)));
typedef unsigned u32x4 __attribute__((ext_vector_type(4)));
typedef unsigned u32x2 __attribute__((ext_vector_type(2)));
typedef unsigned short bf16_t;
constexpr int LDS_BYTES = 159744;
constexpr int LDS_TW_OFF = 139264;
constexpr int LDS_CTL_OFF = 155648;
constexpr size_t WS_BAR = 480 * 1024, WS_BAR_BYTES = 16384;

struct Params {
    const float *x, *c, *ctx, *c_ctx, *w_mod, *b_mod, *norm_mix, *w_in, *q_norm, *k_norm, *conv_w, *conv_b, *fw1, *fb1, *fw2, *fb2, *fw3, *fb3, *fw4, *freq, *hbias,
                *w_oa, *w_oh, *w_out, *norm_ffn, *w_gu, *w_dn, *norm_final;
    float* out; unsigned char* ws;
};

__device__ __forceinline__ unsigned f2bf(float f) { unsigned u = __builtin_bit_cast(unsigned, f); return (u + 0x7fffu + ((u >> 16) & 1u)) >> 16; }
__device__ __forceinline__ unsigned pk2(float lo, float hi) { unsigned r; asm("v_cvt_pk_bf16_f32 %0, %1, %2" : "=v"(r) : "v"(lo), "v"(hi)); return r; }
__device__ __forceinline__ float bflo(unsigned w) { return __builtin_bit_cast(float, w << 16); }
__device__ __forceinline__ float bfhi(unsigned w) { return __builtin_bit_cast(float, w & 0xffff0000u); }
__device__ __forceinline__ float shx(float v, int o, int lane) { return __builtin_bit_cast(float, __builtin_amdgcn_ds_bpermute((lane ^ o) << 2, __builtin_bit_cast(int, v))); }
__device__ __forceinline__ float wave_sum(float v, int lane) {
#pragma unroll
    for (int o = 1; o < 64; o <<= 1) v += shx(v, o, lane);
    return v;
}
__device__ __forceinline__ float sigmoidf_(float v) { return __builtin_amdgcn_rcpf(1.f + __expf(-v)); }
__device__ __forceinline__ int lane_fresh() { int t; asm volatile("v_mbcnt_lo_u32_b32 %0, -1, 0\n\tv_mbcnt_hi_u32_b32 %0, -1, %0" : "=v"(t)); return t; }
namespace pg8 {
#define PG8_LAS __attribute__((address_space(3)))
typedef unsigned short bf16_t;
typedef short bf16x8 __attribute__((ext_vector_type(8)));
typedef float f32x4 __attribute__((ext_vector_type(4)));
typedef unsigned u32x4 __attribute__((ext_vector_type(4)));
constexpr int BM = 256, BK = 64, HALF = 128, HTB = HALF * BK * 2  , STAGE_BYTES = 8 * HTB, NXCD = 8, WGM = 8;

__host__ __device__ __forceinline__ int lds_byte(int r, int c) { const int st = (r >> 4) * 2 + (c >> 5), rr = r & 15, cc = c & 31, ob = rr * 64 + cc * 2; return st * 1024 + (ob ^ (((ob >> 9) & 1) << 5)); }
__host__ __device__ __forceinline__ void stage_rc(int b, int& R, int& C) { const int st = b / 1024, sb = b % 1024, swz = sb ^ (((sb >> 9) & 1) << 5); R = (st >> 1) * 16 + swz / 64; C = (st & 1) * 32 + (swz % 64) / 2; }
__host__ __device__ __forceinline__ int perm32(int rho) { const int n = rho >> 4, i = rho & 15; return 8 * (i >> 2) + 4 * n + (i & 3); }

struct Unit { int pm, pn; };
struct Gemm { const bf16_t* A; const bf16_t* Bt; int M, N, K; };

struct StaticOrder {
    int nM, nN, nwg, G, c;
    __host__ __device__ void init(int M, int N, int G_, int c_) { nM = M / BM; nN = N / BM; nwg = nM * nN; G = G_; c = c_; }
    __host__ __device__ bool next(int i, Unit& u) const {
        const long L = (long)i * G + c; if (L >= nwg) return false;
        int wgid = (int)L; { const int q = nwg / NXCD, r = nwg % NXCD, xcd = wgid % NXCD, off = wgid / NXCD; wgid = (xcd < r ? xcd * (q + 1) : r * (q + 1) + (xcd - r) * q) + off; }
        const int nig = WGM * nN, gid = wgid / nig, fm = gid * WGM, gsz = (nM - fm) < WGM ? (nM - fm) : WGM;
        u.pm = fm + ((wgid % nig) % gsz); u.pn = (wgid % nig) / gsz; return true;
    }
    __device__ __forceinline__ void a_ready(const Unit&) const {}
    __device__ __forceinline__ void done(const Unit&) const {}
};

__device__ __forceinline__ unsigned cvt_pk_bf16(float lo, float hi) { unsigned r; asm volatile("v_cvt_pk_bf16_f32 %0, %1, %2" : "=v"(r) : "v"(lo), "v"(hi)); return r; }
typedef float f32x2 __attribute__((ext_vector_type(2)));
template <class Epi, class Sched, bool ALIGN_EPI = false, bool SP2 = false>
__device__ __forceinline__ void gemm_phase(PG8_LAS unsigned char* lds, const Gemm g, const Sched& S, const Epi& E, const int tid_in) {
    const int tid = tid_in, wid = __builtin_amdgcn_readfirstlane(tid >> 6), lane = tid & 63, wr = wid >> 2, wc = wid & 3, fr = lane & 15, fq = lane >> 4;
    const int K = g.K, nt = K / BK;
    unsigned voffA[2], voffB[2];
#pragma unroll
    for (int i = 0; i < 2; ++i) { int R, C; stage_rc(tid * 16 + i * 8192, R, C); const int Rb = Epi::PERM ? ((R & ~31) + perm32(R & 31)) : R;
        voffA[i] = (unsigned)(R * K + C) * 2u; voffB[i] = (unsigned)(Rb * K + C) * 2u; }
    const size_t kstep = (size_t)(BK * 2);
    const size_t hstep = (size_t)HALF * K * 2;
    const size_t tstep = 2 * hstep;
    const unsigned ldsw = (unsigned)wid * 1024u;
    const int aoff = lds_byte(wr * 64 + fr, fq * 8), boff = lds_byte(wc * 32 + fr, fq * 8);
#define PG8_SA(b, h) (((b) * 2 + (h)) * HTB)
#define PG8_SB(b, h) ((4 + (b) * 2 + (h)) * HTB)
#define PG8_STAGE(bufoff, gbase, voff) do { _Pragma("unroll") for (int _i = 0; _i < 2; ++_i) \
        __builtin_amdgcn_global_load_lds((const unsigned*)((const char*)(gbase) + (voff)[_i]), (PG8_LAS unsigned*)(lds + (bufoff) + ldsw + _i * 8192), 16, 0, 0); } while (0)
#define PG8_LDA(dst, b, h) do { _Pragma("unroll") for (int m = 0; m < 4; ++m) _Pragma("unroll") for (int k = 0; k < 2; ++k) dst[m][k] = *(const PG8_LAS bf16x8*)(lds + PG8_SA(b, h) + aoff + m * 2048 + k * 1024); } while (0)
#define PG8_LDB(dst, b, h) do { _Pragma("unroll") for (int n = 0; n < 2; ++n) _Pragma("unroll") for (int k = 0; k < 2; ++k) dst[n][k] = *(const PG8_LAS bf16x8*)(lds + PG8_SB(b, h) + boff + n * 2048 + k * 1024); } while (0)
#define PG8_MMA(ai, bj, At, Bt) do { __builtin_amdgcn_s_setprio(1); _Pragma("unroll") for (int m = 0; m < 4; ++m) _Pragma("unroll") for (int n = 0; n < 2; ++n) _Pragma("unroll") for (int k = 0; k < 2; ++k) \
        acc[ai][bj][m][n] = __builtin_amdgcn_mfma_f32_16x16x32_bf16(Bt[n][k], At[m][k], acc[ai][bj][m][n], 0, 0, 0); __builtin_amdgcn_s_setprio(0); } while (0)
#define PG8_WAIT_V(n) asm volatile("s_waitcnt vmcnt(" #n ")" ::: "memory")
#define PG8_WAIT_L(n) asm volatile("s_waitcnt lgkmcnt(" #n ")" ::: "memory")
#define PG8_BAR __builtin_amdgcn_s_barrier()
#define PG8_SCHED __builtin_amdgcn_sched_barrier(0)
    Unit cur, nxt; int ui = 0;
    if (!S.next(0, cur)) return;
    f32x4 acc[2][2][4][2];
#pragma unroll
    for (int a = 0; a < 2; ++a)
#pragma unroll
        for (int b = 0; b < 2; ++b)
#pragma unroll
            for (int m = 0; m < 4; ++m)
#pragma unroll
                for (int n = 0; n < 2; ++n) acc[a][b][m][n] = (f32x4){0.f, 0.f, 0.f, 0.f};
    bf16x8 At[4][2], B0[2][2], B1[2][2];
    const char* cA = (const char*)g.A + (size_t)cur.pm * tstep; const char* cB = (const char*)g.Bt + (size_t)cur.pn * tstep;
    S.a_ready(cur);
    if constexpr (SP2) {
        PG8_STAGE(PG8_SB(0, 0), cB, voffB); PG8_STAGE(PG8_SB(0, 1), cB + hstep, voffB); PG8_STAGE(PG8_SA(0, 0), cA, voffA); PG8_STAGE(PG8_SA(0, 1), cA + hstep, voffA);
        if (wr == 1) PG8_BAR;
        PG8_WAIT_V(2); PG8_BAR;
        PG8_STAGE(PG8_SB(1, 0), cB + kstep, voffB); PG8_STAGE(PG8_SA(1, 0), cA + kstep, voffA); PG8_STAGE(PG8_SB(1, 1), cB + hstep + kstep, voffB);
        PG8_WAIT_V(6); PG8_BAR;
    } else {
        PG8_STAGE(PG8_SB(0, 0), cB, voffB); PG8_STAGE(PG8_SA(0, 0), cA, voffA); PG8_STAGE(PG8_SB(0, 1), cB + hstep, voffB); PG8_STAGE(PG8_SA(0, 1), cA + hstep, voffA);
        if (wr == 1) PG8_BAR;
        PG8_WAIT_V(4); PG8_BAR;
        PG8_STAGE(PG8_SB(1, 0), cB + kstep, voffB); PG8_STAGE(PG8_SA(1, 0), cA + kstep, voffA); PG8_STAGE(PG8_SB(1, 1), cB + hstep + kstep, voffB);
        PG8_WAIT_V(6); PG8_BAR;
    }
    for (;;) {
        const bool has_next = S.next(ui + 1, nxt);
        const char* nA = has_next ? (const char*)g.A + (size_t)nxt.pm * tstep : cA; const char* nB = has_next ? (const char*)g.Bt + (size_t)nxt.pn * tstep : cB;
        for (int t = 0; t < nt; t += 2) {
            const bool last = (t == nt - 2);
            const char* a1 = cA + (size_t)(t + 1) * kstep;
            const char* a2 = last ? nA : cA + (size_t)(t + 2) * kstep; const char* b2 = last ? nB : cB + (size_t)(t + 2) * kstep;
            const char* a3 = a2 + kstep; const char* b3 = b2 + kstep;
            if (last && has_next) S.a_ready(nxt);
            if constexpr (SP2) {
            PG8_LDB(B0, 0, 0); PG8_LDB(B1, 0, 1); PG8_SCHED; PG8_LDA(At, 0, 0); PG8_STAGE(PG8_SA(1, 1), a1 + hstep, voffA);
            PG8_WAIT_V(8); PG8_WAIT_L(0); PG8_BAR; PG8_MMA(0, 0, At, B0); PG8_MMA(0, 1, At, B1); PG8_BAR; PG8_SCHED;
            PG8_LDA(At, 0, 1); PG8_STAGE(PG8_SB(0, 0), b2, voffB); PG8_STAGE(PG8_SB(0, 1), b2 + hstep, voffB); PG8_STAGE(PG8_SA(0, 0), a2, voffA);
            PG8_WAIT_V(8); PG8_WAIT_L(0); PG8_BAR; PG8_MMA(1, 0, At, B0); PG8_MMA(1, 1, At, B1); PG8_BAR; PG8_SCHED;
            PG8_LDB(B0, 1, 0); PG8_LDB(B1, 1, 1); PG8_SCHED; PG8_LDA(At, 1, 0); PG8_STAGE(PG8_SA(0, 1), a2 + hstep, voffA);
            PG8_WAIT_V(8); PG8_WAIT_L(0); PG8_BAR; PG8_MMA(0, 0, At, B0); PG8_MMA(0, 1, At, B1); PG8_BAR; PG8_SCHED;
            PG8_LDA(At, 1, 1); PG8_STAGE(PG8_SB(1, 0), b3, voffB); PG8_STAGE(PG8_SB(1, 1), b3 + hstep, voffB); PG8_STAGE(PG8_SA(1, 0), a3, voffA);
            PG8_WAIT_V(8); PG8_WAIT_L(0); PG8_BAR; PG8_MMA(1, 0, At, B0); PG8_MMA(1, 1, At, B1); PG8_BAR; PG8_SCHED;
            } else {
            PG8_LDB(B0, 0, 0); PG8_SCHED; PG8_LDA(At, 0, 0); PG8_STAGE(PG8_SA(1, 1), a1 + hstep, voffA);
            PG8_WAIT_L(8); PG8_BAR; PG8_WAIT_L(0); PG8_MMA(0, 0, At, B0); PG8_BAR; PG8_SCHED;
            PG8_LDB(B1, 0, 1); PG8_STAGE(PG8_SB(0, 0), b2, voffB);
            PG8_BAR; PG8_WAIT_L(0); PG8_MMA(0, 1, At, B1); PG8_BAR;
            PG8_LDA(At, 0, 1); PG8_STAGE(PG8_SA(0, 0), a2, voffA);
            PG8_BAR; PG8_WAIT_L(0); PG8_MMA(1, 0, At, B0); PG8_BAR; PG8_SCHED;
            PG8_STAGE(PG8_SB(0, 1), b2 + hstep, voffB);
            PG8_WAIT_V(6); PG8_BAR; PG8_MMA(1, 1, At, B1); PG8_BAR;
            PG8_LDB(B0, 1, 0); PG8_SCHED; PG8_LDA(At, 1, 0); PG8_STAGE(PG8_SA(0, 1), a2 + hstep, voffA);
            PG8_WAIT_L(8); PG8_BAR; PG8_WAIT_L(0); PG8_MMA(0, 0, At, B0); PG8_BAR; PG8_SCHED;
            PG8_LDB(B1, 1, 1); PG8_STAGE(PG8_SB(1, 0), b3, voffB);
            PG8_BAR; PG8_WAIT_L(0); PG8_MMA(0, 1, At, B1); PG8_BAR;
            PG8_LDA(At, 1, 1); PG8_STAGE(PG8_SA(1, 0), a3, voffA);
            PG8_BAR; PG8_WAIT_L(0); PG8_MMA(1, 0, At, B0); PG8_BAR; PG8_SCHED;
            PG8_STAGE(PG8_SB(1, 1), b3 + hstep, voffB);
            PG8_WAIT_V(6); PG8_BAR; PG8_MMA(1, 1, At, B1); PG8_BAR;
            }
        }
        if constexpr (ALIGN_EPI) { if (wr == 0) PG8_BAR; }
        if constexpr (!Epi::AFTER_DRAIN) { E(acc, cur, wr, wc, fr, fq); S.done(cur); }
        if (!has_next) break;
#pragma unroll
        for (int a = 0; a < 2; ++a)
#pragma unroll
            for (int b = 0; b < 2; ++b)
#pragma unroll
                for (int m = 0; m < 4; ++m)
#pragma unroll
                    for (int n = 0; n < 2; ++n) acc[a][b][m][n] = (f32x4){0.f, 0.f, 0.f, 0.f};
        cur = nxt; cA = nA; cB = nB; ++ui;
        if constexpr (ALIGN_EPI) { if (wr == 1) PG8_BAR; }
    }
    PG8_WAIT_V(0);
    if constexpr (!ALIGN_EPI) { if (wr == 0) PG8_BAR; }
    PG8_BAR;
    if constexpr (Epi::AFTER_DRAIN) { E.fused(acc, cur, wr, wc, fr, fq, lds, wid, lane); S.done(cur); }
#undef PG8_SA
#undef PG8_SB
#undef PG8_STAGE
#undef PG8_LDA
#undef PG8_LDB
#undef PG8_MMA
#undef PG8_WAIT_V
#undef PG8_WAIT_L
#undef PG8_BAR
#undef PG8_SCHED
}
}
namespace pg8 {
__device__ __forceinline__ u32x4 pack8(const f32x4 v0, const f32x4 v1) { u32x4 w; w.x = cvt_pk_bf16(v0[0], v0[1]); w.y = cvt_pk_bf16(v0[2], v0[3]); w.z = cvt_pk_bf16(v1[0], v1[1]); w.w = cvt_pk_bf16(v1[2], v1[3]); return w; }
struct EpiIn {
    static constexpr bool PERM = true, AFTER_DRAIN = false;
    bf16_t *Q, *Kp, *Vp, *HY, *Glat, *Gctx;
    __device__ __forceinline__ void operator()(const f32x4 (&acc)[2][2][4][2], const Unit& u, int wr, int wc, int fr, int fq) const {
        const int pn = u.pn, m0 = u.pm * BM; bf16_t* base; int ldc, colt; size_t rowbase = (size_t)m0;
        if (pn < 4) { base = Q; ldc = 1024; colt = pn * 256; }
        else if (pn < 6) { base = (pn == 4) ? Kp : Vp; ldc = 256; colt = 0; rowbase = (m0 < MLAT) ? (size_t)(m0 >> 13) * KEYS + CTXL + (m0 & 8191) : (size_t)((m0 - MLAT) >> 8) * KEYS; }
        else if (pn < 12) { base = HY; ldc = 1536; colt = (pn - 6) * 256; }
        else { const bool lat = m0 < MLAT; base = lat ? Glat : Gctx; ldc = 2048; colt = (pn - 12) * 256; if (!lat) rowbase = (size_t)(m0 - MLAT); }
        const int col0 = colt + wc * 32 + 8 * fq;
#pragma unroll
        for (int ai = 0; ai < 2; ++ai)
#pragma unroll
            for (int m = 0; m < 4; ++m) { bf16_t* rowp = base + (rowbase + (size_t)(wr * 64 + fr + ai * HALF + m * 16)) * ldc + col0;
#pragma unroll
                for (int bj = 0; bj < 2; ++bj) *(u32x4*)(rowp + bj * HALF) = pack8(acc[ai][bj][m][0], acc[ai][bj][m][1]); }
    }
};
template <bool ADD> struct EpiMerge {
    static constexpr bool PERM = true, AFTER_DRAIN = false;
    const bf16_t *Glat, *Gctx; bf16_t* Mg; int goff;
    static __device__ __forceinline__ f32x2 gate2(unsigned gw, f32x2 a) {
        f32x2 t = (f32x2){bflo(gw), bfhi(gw)} * (-1.4426950408889634f);
        t.x = __builtin_amdgcn_exp2f(t.x); t.y = __builtin_amdgcn_exp2f(t.y);
        t = t + 1.0f;
        t.x = __builtin_amdgcn_rcpf(t.x); t.y = __builtin_amdgcn_rcpf(t.y);
        return a * t;
    }
    __device__ __forceinline__ void operator()(const f32x4 (&acc)[2][2][4][2], const Unit& u, int wr, int wc, int fr, int fq) const {
        const int col0 = u.pn * BM + wc * 32 + 8 * fq;
#pragma unroll
        for (int ai = 0; ai < 2; ++ai)
#pragma unroll
            for (int m = 0; m < 4; ++m) { const size_t row = (size_t)(u.pm * BM + wr * 64 + fr + ai * HALF + m * 16);
                const bf16_t* grow = (u.pm * BM < MLAT) ? Glat + row * GATEW : Gctx + (row - MLAT) * GATEW;
#pragma unroll
                for (int bj = 0; bj < 2; ++bj) {
                    const u32x4 g = *(const u32x4*)(grow + goff + col0 + bj * HALF);
                    const f32x4 a0 = acc[ai][bj][m][0], a1 = acc[ai][bj][m][1];
                    f32x2 r0 = gate2(g.x, (f32x2){a0[0], a0[1]}), r1 = gate2(g.y, (f32x2){a0[2], a0[3]}), r2 = gate2(g.z, (f32x2){a1[0], a1[1]}), r3 = gate2(g.w, (f32x2){a1[2], a1[3]});
                    bf16_t* dst = Mg + row * DM + col0 + bj * HALF;
                    if (ADD) { const u32x4 o = *(const u32x4*)dst;
                        r0 = r0 + (f32x2){bflo(o.x), bfhi(o.x)}; r1 = r1 + (f32x2){bflo(o.y), bfhi(o.y)}; r2 = r2 + (f32x2){bflo(o.z), bfhi(o.z)}; r3 = r3 + (f32x2){bflo(o.w), bfhi(o.w)}; }
                    u32x4 w; w.x = cvt_pk_bf16(r0.x, r0.y); w.y = cvt_pk_bf16(r1.x, r1.y); w.z = cvt_pk_bf16(r2.x, r2.y); w.w = cvt_pk_bf16(r3.x, r3.y);
                    *(u32x4*)dst = w; } }
    }
};
template <bool INF32> struct EpiResid {
    static constexpr bool PERM = false, AFTER_DRAIN = false;
    const float *in_lat, *in_ctx; bf16_t* XS; const float* gate;
    __device__ __forceinline__ void operator()(const f32x4 (&acc)[2][2][4][2], const Unit& u, int wr, int wc, int fr, int fq) const {
        const int m0 = u.pm * BM; const bool lat = m0 < MLAT; const int bidx = lat ? (m0 >> 13) : 8;
        const float* xin = lat ? in_lat + (size_t)m0 * DM : in_ctx + (size_t)(m0 - MLAT) * DM; bf16_t* xs = XS + (size_t)m0 * DM;
        const int col0 = u.pn * BM + wc * 32 + 4 * fq; const float* gp = gate + (size_t)bidx * NMODV + col0;
        f32x4 gv[2][2];
#pragma unroll
        for (int bj = 0; bj < 2; ++bj)
#pragma unroll
            for (int n = 0; n < 2; ++n) gv[bj][n] = *(const f32x4*)(gp + bj * HALF + n * 16);
#pragma unroll
        for (int ai = 0; ai < 2; ++ai)
#pragma unroll
            for (int m = 0; m < 4; ++m) { const size_t off = (size_t)(wr * 64 + fr + ai * HALF + m * 16) * DM + col0;
#pragma unroll
                for (int bj = 0; bj < 2; ++bj)
#pragma unroll
                    for (int n = 0; n < 2; ++n) { f32x4 xi;
                        if (INF32) xi = *(const f32x4*)(xin + off + bj * HALF + n * 16);
                        else { const u32x2 w = *(const u32x2*)(xs + off + bj * HALF + n * 16); xi = (f32x4){bflo(w.x), bfhi(w.x), bflo(w.y), bfhi(w.y)}; }
                        const f32x4 xo = xi + gv[bj][n] * acc[ai][bj][m][n]; u32x2 o; o.x = cvt_pk_bf16(xo[0], xo[1]); o.y = cvt_pk_bf16(xo[2], xo[3]);
                        *(u32x2*)(xs + off + bj * HALF + n * 16) = o; } }
    }
};
struct EpiSwiglu {
    static constexpr bool PERM = true, AFTER_DRAIN = false;
    bf16_t* A;
    __device__ __forceinline__ void operator()(const f32x4 (&acc)[2][2][4][2], const Unit& u, int wr, int wc, int fr, int fq) const {
        const int col0 = u.pn * HALF + wc * 32 + 8 * fq;
#pragma unroll
        for (int ai = 0; ai < 2; ++ai)
#pragma unroll
            for (int m = 0; m < 4; ++m) { const size_t row = (size_t)(u.pm * BM + wr * 64 + fr + ai * HALF + m * 16);
                f32x4 r[2];
#pragma unroll
                for (int n = 0; n < 2; ++n) { const f32x4 g = acc[ai][0][m][n], up = acc[ai][1][m][n];
#pragma unroll
                    for (int e = 0; e < 4; ++e) r[n][e] = g[e] * sigmoidf_(g[e]) * up[e]; }
                *(u32x4*)(A + row * DFF + col0) = pack8(r[0], r[1]); }
    }
};
}
namespace attn {
using bf16 = __hip_bfloat16;
constexpr int D = 128, NW = 8, QBLK = 32, KVBLK = 64;
constexpr float SCALE = 0.088388347648318440f;
constexpr float THR = 8.f;
constexpr int SDEPTH = 2;
constexpr int LDQ = 1024, LDK = 256, LDO = 1024;
constexpr size_t SHM_V = KVBLK * D * 2, SHM_K = KVBLK * D * 2, SHM_ATTN = 2 * SHM_V + 2 * SHM_K + NW * 64 * 4;

using bf16x8 = __attribute__((ext_vector_type(8))) short;
using s16x4  = __attribute__((ext_vector_type(4))) short;
using f32x16 = __attribute__((ext_vector_type(16))) float;
using f32x8  = __attribute__((ext_vector_type(8))) float;
using u32x4  = __attribute__((ext_vector_type(4))) unsigned;
using f32x2  = __attribute__((ext_vector_type(2))) float;
using f32x4  = __attribute__((ext_vector_type(4))) float;
#define KSWZ(row, colB) ((row) * 256 + ((colB) ^ (((row) & 7) << 4)))
#define SBAR() __builtin_amdgcn_sched_barrier(0)
__device__ __forceinline__ int crow(int r, int hi) { return (r & 3) + 8 * (r >> 2) + 4 * hi; }
__device__ __forceinline__ unsigned cvtpk(float lo, float hi) {
  unsigned r; asm volatile("v_cvt_pk_bf16_f32 %0, %1, %2" : "=v"(r) : "v"(lo), "v"(hi)); return r;
}
template <typename TIn> struct Stage;
template <> struct Stage<bf16>  { using T = bf16x8;
  __device__ static __forceinline__ T ld8(const bf16* p) { return *reinterpret_cast<const bf16x8*>(p); }
  __device__ static __forceinline__ bf16x8 tobf(T x) { return x; } };
__device__ __forceinline__ void partialSM(f32x16& p0, f32x16& p1, float& m_reg, float& mn, float& alpha) {
  constexpr float C = SCALE * 1.4426950408889634f;
  float pmax = p0[0]; for (int r = 1; r < 16; ++r) pmax = fmaxf(pmax, p0[r]); for (int r = 0; r < 16; ++r) pmax = fmaxf(pmax, p1[r]);
  { auto rr = __builtin_amdgcn_permlane32_swap(__float_as_uint(pmax), __float_as_uint(pmax), false, false);
    pmax = fmaxf(__uint_as_float(rr[0]), __uint_as_float(rr[1])); }
  if (__builtin_expect(__all(pmax - m_reg <= THR / SCALE), 1)) { mn = m_reg; alpha = 1.f; }
  else { mn = fmaxf(m_reg, pmax); alpha = __builtin_amdgcn_exp2f((m_reg - mn) * C); m_reg = mn; }
  float mnC = -mn * C;
  for (int r = 0; r < 16; ++r) p0[r] = fmaf(p0[r], C, mnC); for (int r = 0; r < 16; ++r) p1[r] = fmaf(p1[r], C, mnC);
  for (int r = 0; r < 16; ++r) p0[r] = __builtin_amdgcn_exp2f(p0[r]);
}
__device__ __forceinline__ void finishSM(f32x16& p0, f32x16& p1, float alpha, float& l_reg, bf16x8& pa0, bf16x8& pa1, bf16x8& pa2, bf16x8& pa3) {
  for (int r = 0; r < 16; ++r) p1[r] = __builtin_amdgcn_exp2f(p1[r]);
  float ps = 0; for (int r = 0; r < 16; ++r) ps += p0[r]; for (int r = 0; r < 16; ++r) ps += p1[r];
  { auto rr = __builtin_amdgcn_permlane32_swap(__float_as_uint(ps), __float_as_uint(ps), false, false);
    ps = __uint_as_float(rr[0]) + __uint_as_float(rr[1]); }
  l_reg = l_reg * alpha + ps;
#define PK4(P, BASE, OUT) do { unsigned a0 = cvtpk(P[BASE + 0], P[BASE + 1]), a1 = cvtpk(P[BASE + 2], P[BASE + 3]);   \
    unsigned b0 = cvtpk(P[BASE + 4], P[BASE + 5]), b1 = cvtpk(P[BASE + 6], P[BASE + 7]);                              \
    auto r0 = __builtin_amdgcn_permlane32_swap(a0, b0, false, false); auto r1 = __builtin_amdgcn_permlane32_swap(a1, b1, false, false); \
    u32x4 w = {r0[0], r1[0], r0[1], r1[1]}; OUT = *reinterpret_cast<bf16x8*>(&w); } while (0)
  PK4(p0, 0, pa0); PK4(p0, 8, pa1); PK4(p1, 0, pa2); PK4(p1, 8, pa3);
#undef PK4
}
__device__ __forceinline__ void qkt(f32x16& p0, f32x16& p1, const bf16* Ks, const bf16x8* qr, int r32, int hi) {
  p0 = f32x16{}; p1 = f32x16{};
  for (int d0 = 0; d0 < 8; ++d0) { int cb = (d0 * 16 + hi * 8) * 2;
    bf16x8 b0 = *reinterpret_cast<const bf16x8*>((const char*)Ks + KSWZ(r32, cb));
    bf16x8 b1 = *reinterpret_cast<const bf16x8*>((const char*)Ks + KSWZ(32 + r32, cb));
    p0 = __builtin_amdgcn_mfma_f32_32x32x16_bf16(b0, qr[d0], p0, 0, 0, 0);
    p1 = __builtin_amdgcn_mfma_f32_32x32x16_bf16(b1, qr[d0], p1, 0, 0, 0); }
}
__device__ __forceinline__ int v_st(int k, int c) { const int kk = (k & ~0xC) | ((k & 4) << 1) | ((k & 8) >> 1); return ((kk >> 3) * 4 + (c >> 5)) * 512 + ((kk & 7) * 32 + (c & 31)) * 2; }
__device__ __forceinline__ int v_rd_base(int lane) { return ((lane & 3) << 3) | (((lane >> 2) & 3) << 6) | (((lane >> 4) & 1) << 5) | (((lane >> 5) & 1) << 8); }
constexpr int v_rd_off(int d0, int ks, int half) { return d0 * 512 + ks * 4096 + half * 2048; }
template <int OFF> __device__ __forceinline__ s16x4 tr_read(int vb) {
  s16x4 r; asm volatile("ds_read_b64_tr_b16 %0, %1 offset:%2" : "=&v"(r) : "v"(vb), "i"(OFF) : "memory"); return r;
}
template <int D0> __device__ __forceinline__ void pv_one(f32x16& od, int vb, bf16x8 pa0, bf16x8 pa1, bf16x8 pa2, bf16x8 pa3) {
  const s16x4 l0 = tr_read<v_rd_off(D0, 0, 0)>(vb), h0 = tr_read<v_rd_off(D0, 0, 1)>(vb), l1 = tr_read<v_rd_off(D0, 1, 0)>(vb), h1 = tr_read<v_rd_off(D0, 1, 1)>(vb);
  const s16x4 l2 = tr_read<v_rd_off(D0, 2, 0)>(vb), h2 = tr_read<v_rd_off(D0, 2, 1)>(vb), l3 = tr_read<v_rd_off(D0, 3, 0)>(vb), h3 = tr_read<v_rd_off(D0, 3, 1)>(vb);
  asm volatile("s_waitcnt lgkmcnt(0)" ::: "memory"); SBAR();
#define PK(L, H) (bf16x8){L[0], L[1], L[2], L[3], H[0], H[1], H[2], H[3]}
  od = __builtin_amdgcn_mfma_f32_32x32x16_bf16(pa0, PK(l0, h0), od, 0, 0, 0);
  od = __builtin_amdgcn_mfma_f32_32x32x16_bf16(pa1, PK(l1, h1), od, 0, 0, 0);
  od = __builtin_amdgcn_mfma_f32_32x32x16_bf16(pa2, PK(l2, h2), od, 0, 0, 0);
  od = __builtin_amdgcn_mfma_f32_32x32x16_bf16(pa3, PK(l3, h3), od, 0, 0, 0);
#undef PK
}
__device__ __forceinline__ void pv_d0(f32x16* o, int vb, bf16x8 pa0, bf16x8 pa1, bf16x8 pa2, bf16x8 pa3) {
  pv_one<0>(o[0], vb, pa0, pa1, pa2, pa3); pv_one<1>(o[1], vb, pa0, pa1, pa2, pa3); pv_one<2>(o[2], vb, pa0, pa1, pa2, pa3); pv_one<3>(o[3], vb, pa0, pa1, pa2, pa3);
}

template <typename TQ>
__device__ __forceinline__ void attn_dense_body(const TQ* Qb, const bf16* __restrict__ Kh, const bf16* __restrict__ Vh,
                                                bf16* Ob, int seq, char* lds, const int tid_in, const float* qgain, const f32x2* rope_rows) {
  using St = Stage<bf16>; using SQ = Stage<TQ>;
  const int tid = tid_in, wid = tid >> 6, lane = tid & 63, r32 = lane & 31, hi = lane >> 5;
  bf16* V_lds = (bf16*)lds; bf16* K_lds = (bf16*)(lds + 2 * SHM_V);
  float* ws = (float*)(lds + 2 * SHM_V + 2 * SHM_K) + wid * 64; float* li_l = ws; float* al_l = ws + 32;
  float m_reg = -1e30f, l_reg = 0; f32x16 o[4] = {}; bf16x8 qr[8];
  const TQ* Qw = Qb + (long)(wid * QBLK + r32) * LDQ + hi * 8;
#pragma unroll
  for (int d0 = 0; d0 < 8; ++d0) qr[d0] = SQ::tobf(SQ::ld8(Qw + d0 * 16));
  {
    float ss = 0.f;
#pragma unroll
    for (int d0 = 0; d0 < 8; ++d0) { const u32x4 w = __builtin_bit_cast(u32x4, qr[d0]);
#pragma unroll
      for (int p = 0; p < 4; ++p) { const float x0 = __uint_as_float(w[p] << 16), x1 = __uint_as_float(w[p] & 0xffff0000u); ss += x0 * x0 + x1 * x1; } }
    { auto rr = __builtin_amdgcn_permlane32_swap(__float_as_uint(ss), __float_as_uint(ss), false, false); ss = __uint_as_float(rr[0]) + __uint_as_float(rr[1]); }
    const float rstd = __builtin_amdgcn_rsqf(ss * (1.f / 128.f) + 1e-6f);
    const float* gq = qgain + hi * 8; const f32x2* rp = rope_rows ? rope_rows + (long)(wid * QBLK + r32) * 64 + hi * 4 : nullptr;
#pragma unroll
    for (int d0 = 0; d0 < 8; ++d0) { u32x4 w = __builtin_bit_cast(u32x4, qr[d0]);
      const f32x4 ga = *(const f32x4*)(gq + d0 * 16), gb = *(const f32x4*)(gq + d0 * 16 + 4);
#pragma unroll
      for (int p = 0; p < 4; ++p) { float x0 = __uint_as_float(w[p] << 16) * rstd * (p < 2 ? ga[(2 * p) & 3] : gb[(2 * p) & 3]), x1 = __uint_as_float(w[p] & 0xffff0000u) * rstd * (p < 2 ? ga[(2 * p + 1) & 3] : gb[(2 * p + 1) & 3]);
        if (rp) { const f32x2 cs = rp[d0 * 8 + p]; const float y0 = x0 * cs.x - x1 * cs.y, y1 = x0 * cs.y + x1 * cs.x; x0 = y0; x1 = y1; }
        w[p] = cvtpk(x0, x1); }
      qr[d0] = __builtin_bit_cast(bf16x8, w); } }
  const int sr = tid >> 4, sc = (tid & 15) * 8, vst0 = v_st(sr, sc), vst1 = v_st(32 + sr, sc);
  const int vb0 = (int)(uintptr_t)V_lds + v_rd_base(lane);
  struct { typename St::T vs0, vs1, ks0, ks1; } sr_[SDEPTH];
#define SLOAD(i, k0) do { sr_[i].vs0 = St::ld8(&Vh[(long)((k0) + sr) * LDK + sc]); sr_[i].vs1 = St::ld8(&Vh[(long)((k0) + 32 + sr) * LDK + sc]); \
    sr_[i].ks0 = St::ld8(&Kh[(long)((k0) + sr) * LDK + sc]); sr_[i].ks1 = St::ld8(&Kh[(long)((k0) + 32 + sr) * LDK + sc]); } while (0)
#define SWRITE(b, i) do { *(bf16x8*)((char*)V_lds + (b) * SHM_V + vst0) = St::tobf(sr_[i].vs0);          \
    *(bf16x8*)((char*)V_lds + (b) * SHM_V + vst1) = St::tobf(sr_[i].vs1); int kc = sc * 2;               \
    *(bf16x8*)((char*)K_lds + (b) * SHM_K + KSWZ(sr, kc)) = St::tobf(sr_[i].ks0);                       \
    *(bf16x8*)((char*)K_lds + (b) * SHM_K + KSWZ(32 + sr, kc)) = St::tobf(sr_[i].ks1); } while (0)
#define SWAIT() do { if constexpr (SDEPTH == 2) asm volatile("s_waitcnt vmcnt(4)" ::: "memory"); else asm volatile("s_waitcnt vmcnt(0)" ::: "memory"); } while (0)
#define RESC(a) do { if (__any((a) < 1.f)) { if (hi == 0) al_l[r32] = (a); asm volatile("s_waitcnt lgkmcnt(0)" ::: "memory"); \
    for (int d = 0; d < 4; ++d) for (int r = 0; r < 16; ++r) o[d][r] *= al_l[crow(r, hi)]; } } while (0)
  f32x16 pA0, pA1, pB0, pB1; float mnA, mnB, alA, alB; bf16x8 pa0, pa1, pa2, pa3; const int NT = seq / KVBLK;
  constexpr int SE = 0, SO = SDEPTH - 1;
  SLOAD(SE, 0); asm volatile("s_waitcnt vmcnt(0)" ::: "memory"); SWRITE(0, SE); __syncthreads();
  qkt(pA0, pA1, K_lds, qr, r32, hi); partialSM(pA0, pA1, m_reg, mnA, alA);
  SLOAD(SO, KVBLK); if constexpr (SDEPTH == 2) { if (2 < NT) SLOAD(SE, 2 * KVBLK); }
  SWAIT(); SWRITE(1, SO); __syncthreads();
  for (int j = 1; j + 1 < NT; j += 2) {
    SBAR(); qkt(pB0, pB1, (bf16*)((char*)K_lds + SHM_K), qr, r32, hi);
    finishSM(pA0, pA1, alA, l_reg, pa0, pa1, pa2, pa3); SBAR();
    SLOAD(SO, (j + SDEPTH) * KVBLK); SBAR();
    pv_d0(o, vb0, pa0, pa1, pa2, pa3); partialSM(pB0, pB1, m_reg, mnB, alB);
    __syncthreads(); SWAIT(); SWRITE(0, SE);
    RESC(alB); __syncthreads();
    SBAR(); qkt(pA0, pA1, K_lds, qr, r32, hi);
    finishSM(pB0, pB1, alB, l_reg, pa0, pa1, pa2, pa3); SBAR();
    if (SDEPTH == 1 || j + 3 < NT) SLOAD(SE, (j + 1 + SDEPTH) * KVBLK); SBAR();
    pv_d0(o, vb0 + (int)SHM_V, pa0, pa1, pa2, pa3); partialSM(pA0, pA1, m_reg, mnA, alA);
    __syncthreads(); SWAIT(); SWRITE(1, SO);
    RESC(alA); __syncthreads();
  }
  SBAR(); qkt(pB0, pB1, (bf16*)((char*)K_lds + SHM_K), qr, r32, hi);
  finishSM(pA0, pA1, alA, l_reg, pa0, pa1, pa2, pa3); SBAR();
  pv_d0(o, vb0, pa0, pa1, pa2, pa3); partialSM(pB0, pB1, m_reg, mnB, alB);
  __syncthreads(); RESC(alB);
  finishSM(pB0, pB1, alB, l_reg, pa0, pa1, pa2, pa3); SBAR();
  pv_d0(o, vb0 + (int)SHM_V, pa0, pa1, pa2, pa3);
  if (hi == 0) li_l[r32] = l_reg; asm volatile("s_waitcnt lgkmcnt(0)" ::: "memory");
  float rli[16];
#pragma unroll
  for (int r = 0; r < 16; ++r) rli[r] = __builtin_amdgcn_rcpf(li_l[crow(r, hi)]);
  unsigned short* Ow = (unsigned short*)Ob + (long)(wid * QBLK) * LDO;
#pragma unroll
  for (int r = 0; r < 16; ++r) { int orow = crow(r, hi);
    for (int d0 = 0; d0 < 4; ++d0) Ow[(long)orow * LDO + d0 * 32 + r32] = (unsigned short)(cvtpk(o[d0][r] * rli[r], 0.f) & 0xffffu); }
#undef SLOAD
#undef SWRITE
#undef SWAIT
#undef RESC
}

}
#define XB_TMO      128
#define XB_XCNT(j)  (256  + 64 * (j))
#define XB_XSUB(j)  (1280 + 64 * (j))
#define XB_XGEN(j)  (2304 + 64 * (j))
#define XB_TOP      3328
#define XB_TOPGEN   3392
#define XCD_BAR_WORDS 3456
#define XB_SPIN_CAP (1u << 18)

__device__ __forceinline__ unsigned xb_ld(unsigned* p)              { return __hip_atomic_load(p, __ATOMIC_RELAXED, __HIP_MEMORY_SCOPE_AGENT); }
__device__ __forceinline__ unsigned xb_add(unsigned* p, unsigned v) { return __hip_atomic_fetch_add(p, v, __ATOMIC_RELAXED, __HIP_MEMORY_SCOPE_AGENT); }
__device__ __forceinline__ unsigned xb_xcc_id() { return (unsigned)__builtin_amdgcn_s_getreg((3 << 11) | 20) & 0xFu; }
#define XB_SPIN(cond, bar) do { unsigned _sp = 0; while (cond) { __builtin_amdgcn_s_sleep(1); \
    if ((++_sp & 255u) == 0u) { if (xb_ld(&(bar)[XB_TMO])) break; if (_sp > XB_SPIN_CAP) { atomicAdd(&(bar)[XB_TMO], 1u); break; } } } } while (0)

struct XcdBarrier {
    int tid; unsigned* bar; unsigned x;
    volatile LAS unsigned* st;
};

__device__ __forceinline__ XcdBarrier xcd_barrier_post(unsigned* bar, volatile LAS unsigned* st, int tid) {
    XcdBarrier b; b.tid = tid; b.bar = bar; b.x = xb_xcc_id(); b.st = st;
    if (b.tid == 0) (void)xb_add(&bar[XB_XCNT(b.x)], 1u);
    return b;
}
__device__ __forceinline__ void xcd_barrier_complete(unsigned* bar, unsigned x, unsigned& nloc, unsigned& nx) {
    const unsigned G = gridDim.x * gridDim.y * gridDim.z;
    unsigned sum, cnt, mine, sp = 0u;
    for (;;) {
        sum = 0u; cnt = 0u; mine = 0u;
#pragma unroll
        for (unsigned j = 0; j < 16; ++j) { const unsigned c = xb_ld(&bar[XB_XCNT(j)]); sum += c; cnt += (c > 0u) ? 1u : 0u; mine = (j == x) ? c : mine; }
        if (sum == G) break;
        __builtin_amdgcn_s_sleep(1);
        if ((++sp & 255u) == 0u) { if (xb_ld(&bar[XB_TMO])) break; if (sp > XB_SPIN_CAP) { atomicAdd(&bar[XB_TMO], 1u); break; } }
    }
    nloc = mine > 0u ? mine : 1u; nx = cnt > 0u ? cnt : 1u;
}

__device__ __forceinline__ void xcd_barrier(const XcdBarrier& b) {
    asm volatile("s_waitcnt vmcnt(0)" ::: "memory");
    __syncthreads();
    if (b.tid == 0) {
        unsigned* bar = b.bar;
        __builtin_amdgcn_s_waitcnt(0);
        unsigned nloc = b.st[0], nx = b.st[1];
        const unsigned old = xb_add(&bar[XB_XSUB(b.x)], 1u);
        const unsigned gen = old / nloc;
        if (old + 1u == (gen + 1u) * nloc) {
            __builtin_amdgcn_fence(__ATOMIC_RELEASE, "agent");
            asm volatile("s_waitcnt vmcnt(0)" ::: "memory");
            const unsigned og = xb_add(&bar[XB_TOP], 1u);
            const unsigned tg = og / nx;
            if (og + 1u == (tg + 1u) * nx) xb_add(&bar[XB_TOPGEN], 1u);
            else XB_SPIN(xb_ld(&bar[XB_TOPGEN]) == tg, bar);
            __builtin_amdgcn_fence(__ATOMIC_ACQUIRE, "agent");
            xb_add(&bar[XB_XGEN(b.x)], 1u);
            asm volatile("s_waitcnt vmcnt(0)" ::: "memory");
        } else {
            XB_SPIN(xb_ld(&bar[XB_XGEN(b.x)]) == gen, bar);
            __builtin_amdgcn_fence(__ATOMIC_ACQUIRE, "agent");
            asm volatile("s_waitcnt vmcnt(0)" ::: "memory");
        }
    }
    __syncthreads();
}

#define LDS_WAIT() asm volatile("s_waitcnt lgkmcnt(0)" ::: "memory")
__device__ __forceinline__ void transpose_item(const float* W, int K, int N, bf16_t* WT, int k0, int n0, int drow0, LAS float* scr, int lane) {
#pragma unroll
    for (int i = 0; i < 32; ++i) { const int kk = 2 * i + (lane >> 5); scr[kk * 33 + (lane & 31)] = W[(size_t)(k0 + kk) * N + n0 + (lane & 31)]; }
    LDS_WAIT(); asm volatile("" ::: "memory");
    const int c = lane & 7;
#pragma unroll
    for (int j = 0; j < 4; ++j) { const int n = (lane >> 3) + 8 * j; const LAS float* s = scr + (8 * c) * 33 + n;
        u32x4 o; o.x = pk2(s[0 * 33], s[1 * 33]); o.y = pk2(s[2 * 33], s[3 * 33]); o.z = pk2(s[4 * 33], s[5 * 33]); o.w = pk2(s[6 * 33], s[7 * 33]);
        *(u32x4*)(WT + (size_t)(drow0 + n) * K + k0 + 8 * c) = o; }
    LDS_WAIT(); asm volatile("" ::: "memory");
}
__device__ __forceinline__ void phase_weights(const Params& p, LAS unsigned char* lds, int gw, int NGW, int wave, int lane) {
    LAS float* scr = (LAS float*)(lds + wave * 16384);
    constexpr int I0 = 16 * 160, I1 = 16 * 32, I2 = 8 * 32, I3 = 16 * 32, I4 = 16 * 176, I5 = 44 * 32, IL = I0 + I1 + I2 + I3 + I4 + I5;
    for (int it = gw; it < 2 * IL; it += NGW) {
        const int l = it / IL; int r = it % IL; unsigned char* wb = p.ws + WS_W + (size_t)l * WL_STRIDE;
        if (r < I0) { const int kb = r / 160, nb = r % 160; transpose_item(p.w_in + (size_t)l * DM * PROJ, DM, PROJ, (bf16_t*)(wb + WL_IN), kb * 64, nb * 32, nb * 32, scr, lane); continue; } r -= I0;
        if (r < I1) { const int kb = r / 32, nb = r % 32; transpose_item(p.w_oa + (size_t)l * DM * DM, DM, DM, (bf16_t*)(wb + WL_OA), kb * 64, nb * 32, nb * 32, scr, lane); continue; } r -= I1;
        if (r < I2) { const int kb = r / 32, nb = r % 32; transpose_item(p.w_oh + (size_t)l * HYW * DM, HYW, DM, (bf16_t*)(wb + WL_OH), kb * 64, nb * 32, nb * 32, scr, lane); continue; } r -= I2;
        if (r < I3) { const int kb = r / 32, nb = r % 32; transpose_item(p.w_out + (size_t)l * DM * DM, DM, DM, (bf16_t*)(wb + WL_OUT), kb * 64, nb * 32, nb * 32, scr, lane); continue; } r -= I3;
        if (r < I4) { const int kb = r / 176, nb = r % 176; const int n0 = nb * 32; const int nn = n0 < DFF ? n0 : n0 - DFF; const int drow = 256 * (nn / 128) + (nn % 128) + (n0 < DFF ? 0 : 128);
            transpose_item(p.w_gu + (size_t)l * DM * 2 * DFF, DM, 2 * DFF, (bf16_t*)(wb + WL_GU), kb * 64, n0, drow, scr, lane); continue; } r -= I4;
        { const int kb = r / 32, nb = r % 32; transpose_item(p.w_dn + (size_t)l * DFF * DM, DFF, DM, (bf16_t*)(wb + WL_DN), kb * 64, nb * 32, nb * 32, scr, lane); }
    }
}
__device__ __forceinline__ void mod_unit(const Params& p, int unit, LAS unsigned char* lds, int tid) {
    LAS float* s = (LAS float*)lds; LAS float* red = (LAS float*)(lds + 40960);
    const int l = unit / 96, n0 = (unit % 96) * 64, col = tid & 63, ks = tid >> 6;
    for (int e = tid; e < 9 * 1024; e += 512) { const float v = e < 8192 ? p.c[e] : p.c_ctx[e - 8192]; s[e] = v / (1.f + __expf(-v)); }
    __syncthreads();
    const float* W = p.w_mod + (size_t)l * DM * NMODV + n0 + col;
    float acc[9];
#pragma unroll
    for (int j = 0; j < 9; ++j) acc[j] = 0.f;
#pragma unroll 2
    for (int k = ks * 128; k < ks * 128 + 128; k += 4) {
        const float w0 = W[(size_t)k * NMODV], w1 = W[(size_t)(k + 1) * NMODV], w2 = W[(size_t)(k + 2) * NMODV], w3 = W[(size_t)(k + 3) * NMODV];
#pragma unroll
        for (int j = 0; j < 9; ++j) { const f32x4 sv = *(const LAS f32x4*)(s + j * 1024 + k); acc[j] += sv[0] * w0 + sv[1] * w1 + sv[2] * w2 + sv[3] * w3; }
    }
#pragma unroll
    for (int j = 0; j < 9; ++j) red[(ks * 9 + j) * 64 + col] = acc[j];
    __syncthreads();
    for (int e = tid; e < 9 * 64; e += 512) { const int j = e >> 6, c = e & 63; float sum = 0.f;
#pragma unroll
        for (int q = 0; q < 8; ++q) sum += red[(q * 9 + j) * 64 + c];
        ((float*)(p.ws + WS_MOD))[((size_t)l * 9 + j) * NMODV + n0 + c] = sum + p.b_mod[(size_t)l * NMODV + n0 + c]; }
    __syncthreads();
}
__device__ __forceinline__ void shiftw_unit(const float* sbase, const float* W, int ldw, int n0, float* out, int ldo, LAS unsigned char* lds, int tid) {
    LAS float* s = (LAS float*)lds; LAS float* red = (LAS float*)(lds + 40960);
    const int col = tid & 63, ks = tid >> 6;
    for (int e = tid; e < 9 * 1024; e += 512) s[e] = sbase[(size_t)(e >> 10) * NMODV + (e & 1023)];
    __syncthreads();
    const float* Wc = W + n0 + col;
    float acc[9];
#pragma unroll
    for (int j = 0; j < 9; ++j) acc[j] = 0.f;
#pragma unroll 2
    for (int k = ks * 128; k < ks * 128 + 128; k += 4) {
        const float w0 = Wc[(size_t)k * ldw], w1 = Wc[(size_t)(k + 1) * ldw], w2 = Wc[(size_t)(k + 2) * ldw], w3 = Wc[(size_t)(k + 3) * ldw];
#pragma unroll
        for (int j = 0; j < 9; ++j) { const f32x4 sv = *(const LAS f32x4*)(s + j * 1024 + k); acc[j] += sv[0] * w0 + sv[1] * w1 + sv[2] * w2 + sv[3] * w3; }
    }
#pragma unroll
    for (int j = 0; j < 9; ++j) red[(ks * 9 + j) * 64 + col] = acc[j];
    __syncthreads();
    for (int e = tid; e < 9 * 64; e += 512) { const int j = e >> 6, c = e & 63; float sum = 0.f;
#pragma unroll
        for (int qq = 0; qq < 8; ++qq) sum += red[(qq * 9 + j) * 64 + c];
        out[(size_t)j * ldo + n0 + c] = sum; }
    __syncthreads();
}
__device__ __forceinline__ void filter_unit(const Params& p, int l, int L, int t0, float* dst, bool transposed, LAS unsigned char* lds, int tid) {
    LAS float* z = (LAS float*)lds; LAS float* h1 = z + 1024; LAS float* h2 = h1 + 1024; LAS float* h3 = h2 + 1024;
    const float wstep = (float)(2.0 * 3.14159265358979323846 / (double)L), invL1 = 1.f / (float)(L - 1);
    for (int e = tid; e < 16 * 33; e += 512) { const int tl = e / 33, i = e % 33; const float tf = (float)(t0 + tl); float val;
        if (i == 0) val = tf * invL1;
        else { const int j = (i - 1) & 15; const float f = 1e-4f + (float)j * ((15.f - 1e-4f) / 15.f); const float a = f * (wstep * tf); val = (i <= 16) ? cosf(a) : -sinf(a); }
        z[tl * 36 + i] = val; }
    __syncthreads();
    const float* fr = p.freq + (size_t)l * 3 * 64;
    for (int e = tid; e < 1024; e += 512) { const int tl = e >> 6, m = e & 63; const float* w = p.fw1 + (size_t)l * 33 * 64 + m; float sacc = p.fb1[l * 64 + m];
#pragma unroll 3
        for (int i = 0; i < 33; ++i) sacc += z[tl * 36 + i] * w[i * 64];
        h1[e] = sinf(fr[m] * sacc); }
    __syncthreads();
    for (int e = tid; e < 1024; e += 512) { const int tl = e >> 6, m = e & 63; const float* w = p.fw2 + (size_t)l * 64 * 64 + m; float sacc = p.fb2[l * 64 + m];
#pragma unroll 4
        for (int i = 0; i < 64; ++i) sacc += h1[tl * 64 + i] * w[i * 64];
        h2[e] = sinf(fr[64 + m] * sacc); }
    __syncthreads();
    for (int e = tid; e < 1024; e += 512) { const int tl = e >> 6, m = e & 63; const float* w = p.fw3 + (size_t)l * 64 * 64 + m; float sacc = p.fb3[l * 64 + m];
#pragma unroll 4
        for (int i = 0; i < 64; ++i) sacc += h2[tl * 64 + i] * w[i * 64];
        h3[e] = sinf(fr[128 + m] * sacc); }
    __syncthreads();
    const float mind = -3.0701134573253945f, maxd = -15.350567286626972f;
#pragma unroll 1
    for (int r = 0; r < 2; ++r) { const int o = tid + 512 * r; const float* w4 = p.fw4 + (size_t)l * 64 * 1024 + o; float acc[16];
#pragma unroll
        for (int tl = 0; tl < 16; ++tl) acc[tl] = 0.f;
#pragma unroll 2
        for (int m = 0; m < 64; ++m) { const float w = w4[(size_t)m * 1024];
#pragma unroll
            for (int tl = 0; tl < 16; ++tl) acc[tl] += h3[tl * 64 + m] * w; }
        const int c = o & 511; const float delta = fabsf(mind + (float)c * ((maxd - mind) / 511.f));
#pragma unroll
        for (int tl = 0; tl < 16; ++tl) acc[tl] *= expf(-((float)(t0 + tl) * invL1) * delta);
        if (transposed) { float* d = dst + (size_t)o * SEQ + t0;
#pragma unroll
            for (int q = 0; q < 4; ++q) *(f32x4*)(d + 4 * q) = (f32x4){acc[4 * q], acc[4 * q + 1], acc[4 * q + 2], acc[4 * q + 3]}; }
        else {
#pragma unroll
            for (int tl = 0; tl < 16; ++tl) dst[(size_t)(t0 + tl) * 1024 + o] = acc[tl]; }
    }
    __syncthreads();
}
__device__ __forceinline__ f32x2 cmul(f32x2 a, f32x2 b) { return (f32x2){a.x * b.x - a.y * b.y, a.x * b.y + a.y * b.x}; }
__device__ __forceinline__ int PADI(int i) { return i + 4 * (i >> 6); }
__device__ __forceinline__ f32x2 tw_get(const LAS f32x2* T, int k) { const f32x2 h = T[k & 2047]; const float c = 0.70710678118654752f; const f32x2 r = {(h.x + h.y) * c, (h.y - h.x) * c}; return (k & 2048) ? r : h; }
__device__ __forceinline__ void bfly_fwd(f32x2& a, f32x2& b, f32x2& c, f32x2& d, f32x2 w1) {
    const f32x2 w2 = cmul(w1, w1), w3 = cmul(w2, w1);
    const f32x2 s0 = a + c, s1 = a - c, s2 = b + d, s3 = b - d;
    a = s0 + s2; b = cmul((f32x2){s1.x + s3.y, s1.y - s3.x}, w1); c = cmul(s0 - s2, w2); d = cmul((f32x2){s1.x - s3.y, s1.y + s3.x}, w3);
}
__device__ __forceinline__ void bfly_inv(f32x2& a, f32x2& b, f32x2& c, f32x2& d, f32x2 w1c) {
    const f32x2 w2 = cmul(w1c, w1c), w3 = cmul(w2, w1c);
    b = cmul(b, w1c); c = cmul(c, w2); d = cmul(d, w3);
    const f32x2 s0 = a + c, s1 = a - c, s2 = b + d, s3 = b - d;
    a = s0 + s2; b = (f32x2){s1.x - s3.y, s1.y + s3.x}; c = s0 - s2; d = (f32x2){s1.x + s3.y, s1.y - s3.x};
}
__device__ __forceinline__ void bfly_fwd1(f32x2& a, f32x2& b, f32x2& c, f32x2& d) {
    const f32x2 s0 = a + c, s1 = a - c, s2 = b + d, s3 = b - d;
    a = s0 + s2; b = (f32x2){s1.x + s3.y, s1.y - s3.x}; c = s0 - s2; d = (f32x2){s1.x - s3.y, s1.y + s3.x};
}
__device__ __forceinline__ void bfly_inv1(f32x2& a, f32x2& b, f32x2& c, f32x2& d) {
    const f32x2 s0 = a + c, s1 = a - c, s2 = b + d, s3 = b - d;
    a = s0 + s2; b = (f32x2){s1.x - s3.y, s1.y + s3.x}; c = s0 - s2; d = (f32x2){s1.x + s3.y, s1.y - s3.x};
}
template <int PS> __device__ __forceinline__ void fwd2_regs(f32x2 (&e)[4][4], const LAS f32x2* tw, int j) {
    constexpr int q16 = (NFFT >> (2 * PS)) / 16;
#pragma unroll
    for (int k2 = 0; k2 < 4; ++k2) bfly_fwd(e[0][k2], e[1][k2], e[2][k2], e[3][k2], tw_get(tw, (j + k2 * q16) << (2 * PS)));
    const f32x2 w1 = tw_get(tw, j << (2 * PS + 2));
#pragma unroll
    for (int k1 = 0; k1 < 4; ++k1) bfly_fwd(e[k1][0], e[k1][1], e[k1][2], e[k1][3], w1);
}
template <int PS> __device__ __forceinline__ void inv2_regs(f32x2 (&e)[4][4], const LAS f32x2* tw, int j) {
    constexpr int q16 = (NFFT >> (2 * PS)) / 16;
    f32x2 w1 = tw_get(tw, j << (2 * PS + 2)); w1.y = -w1.y;
#pragma unroll
    for (int k1 = 0; k1 < 4; ++k1) bfly_inv(e[k1][0], e[k1][1], e[k1][2], e[k1][3], w1);
#pragma unroll
    for (int k2 = 0; k2 < 4; ++k2) { f32x2 w = tw_get(tw, (j + k2 * q16) << (2 * PS)); w.y = -w.y; bfly_inv(e[0][k2], e[1][k2], e[2][k2], e[3][k2], w); }
}
template <int PS, bool INV> __device__ __forceinline__ void fft_pass2_lds(LAS f32x2* X, const LAS f32x2* tw, int tid) {
    constexpr int lq = 10 - 2 * PS;
#pragma unroll
    for (int w = tid; w < 1024; w += 512) {
        const int j = w & ((1 << lq) - 1), base = ((w >> lq) << (lq + 4)) + j;
        f32x2 e[4][4];
#pragma unroll
        for (int k = 0; k < 16; ++k) e[k >> 2][k & 3] = X[PADI(base + (k << lq))];
        if (INV) inv2_regs<PS>(e, tw, j); else fwd2_regs<PS>(e, tw, j);
#pragma unroll
        for (int k = 0; k < 16; ++k) X[PADI(base + (k << lq))] = e[k >> 2][k & 3];
    }
    __syncthreads();
}
__device__ __forceinline__ void kf_unit(const float* filtT, f32x2* KF, int c, LAS unsigned char* lds, int tid) {
    const LAS f32x2* tw = (const LAS f32x2*)(lds + LDS_TW_OFF);
    LAS f32x2* X = (LAS f32x2*)lds;
    const float* hf = filtT + (size_t)c * SEQ; const float* hb = filtT + (size_t)(HYW + c) * SEQ;
    for (int n = tid; n < SEQ; n += 512) { X[PADI(n)] = (f32x2){hf[n], 0.f}; X[PADI(SEQ + n)] = (f32x2){n == 0 ? 0.f : hb[SEQ - n], 0.f}; }
    __syncthreads();
    fft_pass2_lds<0, false>(X, tw, tid); fft_pass2_lds<2, false>(X, tw, tid); fft_pass2_lds<4, false>(X, tw, tid);
    f32x2* o = KF + (size_t)c * NFFT;
    for (int w = tid; w < 4096; w += 512) { const int p0 = PADI(4 * w); f32x2 a = X[p0], b = X[p0 + 1], cc = X[p0 + 2], d = X[p0 + 3];
        bfly_fwd1(a, b, cc, d); const float sc = 1.f / (float)NFFT;
        *(f32x4*)(o + 4 * w) = (f32x4){a.x * sc, a.y * sc, b.x * sc, b.y * sc}; *(f32x4*)(o + 4 * w + 2) = (f32x4){cc.x * sc, cc.y * sc, d.x * sc, d.y * sc}; }
    __syncthreads();
}
__device__ __forceinline__ void fftconv_units(bf16_t* VT, const f32x2* KF, int nunits, int bid, int G, LAS unsigned char* lds, int tid) {
    LAS f32x2* X = (LAS f32x2*)lds; const LAS f32x2* tw = (const LAS f32x2*)(lds + LDS_TW_OFF);
    const int w2 = 2 * tid;
    unsigned pre0[8], pre1[8];
    if (bid < nunits) { const bf16_t* s0 = VT + ((size_t)(bid >> 2) * NB + 2 * (bid & 3)) * SEQ;
#pragma unroll
        for (int k = 0; k < 8; ++k) { pre0[k] = *(const unsigned*)(s0 + w2 + (k << 10)); pre1[k] = *(const unsigned*)(s0 + SEQ + w2 + (k << 10)); } }
    for (int u = bid; u < nunits; u += G) {
        const int c = u >> 2, pair = u & 3;
        bf16_t* s0 = VT + ((size_t)c * NB + 2 * pair) * SEQ; bf16_t* s1 = s0 + SEQ;
        { f32x2 ea[4][4], eb[4][4];
#pragma unroll
          for (int k = 0; k < 8; ++k) { ea[k >> 2][k & 3] = (f32x2){bflo(pre0[k]), bflo(pre1[k])}; eb[k >> 2][k & 3] = (f32x2){bfhi(pre0[k]), bfhi(pre1[k])}; }
#pragma unroll
          for (int k = 8; k < 16; ++k) { ea[k >> 2][k & 3] = (f32x2){0.f, 0.f}; eb[k >> 2][k & 3] = (f32x2){0.f, 0.f}; }
          fwd2_regs<0>(ea, tw, w2); fwd2_regs<0>(eb, tw, w2 + 1);
#pragma unroll
          for (int k = 0; k < 16; ++k) { const int pi = PADI(w2 + (k << 10)); *(LAS f32x4*)(X + pi) = (f32x4){ea[k >> 2][k & 3].x, ea[k >> 2][k & 3].y, eb[k >> 2][k & 3].x, eb[k >> 2][k & 3].y}; } }
        __syncthreads();
        fft_pass2_lds<2, false>(X, tw, tid); fft_pass2_lds<4, false>(X, tw, tid);
        const f32x2* kf = KF + (size_t)c * NFFT;
#pragma unroll 2
        for (int w = tid; w < 4096; w += 512) { const int p0 = PADI(4 * w); f32x2 a = X[p0], b = X[p0 + 1], cc = X[p0 + 2], d = X[p0 + 3];
            const f32x4 k01 = *(const f32x4*)(kf + 4 * w), k23 = *(const f32x4*)(kf + 4 * w + 2);
            bfly_fwd1(a, b, cc, d);
            a = cmul(a, (f32x2){k01[0], k01[1]}); b = cmul(b, (f32x2){k01[2], k01[3]}); cc = cmul(cc, (f32x2){k23[0], k23[1]}); d = cmul(d, (f32x2){k23[2], k23[3]});
            bfly_inv1(a, b, cc, d);
            X[p0] = a; X[p0 + 1] = b; X[p0 + 2] = cc; X[p0 + 3] = d; }
        __syncthreads();
        if (u + G < nunits) { const int un = u + G; const bf16_t* n0 = VT + ((size_t)(un >> 2) * NB + 2 * (un & 3)) * SEQ;
#pragma unroll
            for (int k = 0; k < 8; ++k) { pre0[k] = *(const unsigned*)(n0 + w2 + (k << 10)); pre1[k] = *(const unsigned*)(n0 + SEQ + w2 + (k << 10)); } }
        fft_pass2_lds<4, true>(X, tw, tid); fft_pass2_lds<2, true>(X, tw, tid);
        { f32x2 ea[4][4], eb[4][4];
#pragma unroll
          for (int k = 0; k < 16; ++k) { const f32x4 v = *(const LAS f32x4*)(X + PADI(w2 + (k << 10))); ea[k >> 2][k & 3] = (f32x2){v[0], v[1]}; eb[k >> 2][k & 3] = (f32x2){v[2], v[3]}; }
          inv2_regs<0>(ea, tw, w2); inv2_regs<0>(eb, tw, w2 + 1);
#pragma unroll
          for (int k = 0; k < 8; ++k) { *(unsigned*)(s0 + w2 + (k << 10)) = pk2(ea[k >> 2][k & 3].x, eb[k >> 2][k & 3].x); *(unsigned*)(s1 + w2 + (k << 10)) = pk2(ea[k >> 2][k & 3].y, eb[k >> 2][k & 3].y); } }
        __syncthreads();
    }
}
struct SC8 { float v[8]; };
constexpr int LDS_CW_OFF = 98304;
__device__ __forceinline__ void stage_conv_weights(const float* cw, const float* cb, LAS unsigned char* lds, int tid) {
    LAS float* d = (LAS float*)(lds + LDS_CW_OFF);
    for (int e = tid; e < 3 * HYP; e += 512) d[e] = cw[e];
    for (int e = tid; e < HYP; e += 512) d[3 * HYP + e] = cb[e];
    __syncthreads();
}
__device__ __forceinline__ SC8 short_conv8(const bf16_t* hy0, int t, int len, int col, const LAS float* cwl) {
    const u32x4 z4 = {0u, 0u, 0u, 0u};
    const u32x4 um = t > 0 ? *(const u32x4*)(hy0 + (size_t)(t - 1) * HYP + col) : z4;
    const u32x4 u0 = *(const u32x4*)(hy0 + (size_t)t * HYP + col);
    const u32x4 up = t + 1 < len ? *(const u32x4*)(hy0 + (size_t)(t + 1) * HYP + col) : z4;
    const f32x4 w0a = *(const LAS f32x4*)(cwl + col), w0b = *(const LAS f32x4*)(cwl + col + 4), w1a = *(const LAS f32x4*)(cwl + HYP + col), w1b = *(const LAS f32x4*)(cwl + HYP + col + 4),
                w2a = *(const LAS f32x4*)(cwl + 2 * HYP + col), w2b = *(const LAS f32x4*)(cwl + 2 * HYP + col + 4), ba = *(const LAS f32x4*)(cwl + 3 * HYP + col), bb = *(const LAS f32x4*)(cwl + 3 * HYP + col + 4);
    SC8 r;
#pragma unroll
    for (int e = 0; e < 4; ++e) {
        const unsigned a = um[e], b = u0[e], c = up[e]; const int k = 2 * e;
        const float w0l = k < 4 ? w0a[k & 3] : w0b[k & 3], w1l = k < 4 ? w1a[k & 3] : w1b[k & 3], w2l = k < 4 ? w2a[k & 3] : w2b[k & 3], bl = k < 4 ? ba[k & 3] : bb[k & 3];
        const float w0h = k < 4 ? w0a[(k + 1) & 3] : w0b[(k + 1) & 3], w1h = k < 4 ? w1a[(k + 1) & 3] : w1b[(k + 1) & 3], w2h = k < 4 ? w2a[(k + 1) & 3] : w2b[(k + 1) & 3], bh = k < 4 ? ba[(k + 1) & 3] : bb[(k + 1) & 3];
        r.v[k] = bflo(a) * w0l + bflo(b) * w1l + bflo(c) * w2l + bl;
        r.v[k + 1] = bfhi(a) * w0h + bfhi(b) * w1h + bfhi(c) * w2h + bh;
    }
    return r;
}
__device__ __forceinline__ void hy_pre_unit(const bf16_t* HY, bf16_t* VT, int unit, LAS unsigned char* lds, int tid) {
    const LAS float* cwl = (const LAS float*)(lds + LDS_CW_OFF);
    const int cp = unit & 3, tt = (unit >> 2) & 127, b = unit >> 9, t0 = tt * 64;
    { const int tl = tid >> 3, c8 = (tid & 7) * 8; const bf16_t* hy0 = HY + (size_t)b * SEQ * HYP;
      SC8 x1[2], vv[2];
#pragma unroll
      for (int r = 0; r < 2; ++r) { const int c0 = (cp * 2 + r) * 64; x1[r] = short_conv8(hy0, t0 + tl, SEQ, 512 + c0 + c8, cwl); vv[r] = short_conv8(hy0, t0 + tl, SEQ, 1024 + c0 + c8, cwl); }
#pragma unroll
      for (int r = 0; r < 2; ++r) { LAS float* T = (LAS float*)lds + r * 4160;
#pragma unroll
          for (int e = 0; e < 8; ++e) T[(c8 + e) * 65 + tl] = x1[r].v[e] * vv[r].v[e]; } }
    __syncthreads();
    { const int cl = tid >> 3, t8 = (tid & 7) * 8;
#pragma unroll
      for (int r = 0; r < 2; ++r) { const int c0 = (cp * 2 + r) * 64; bf16_t* o = VT + ((size_t)(c0 + cl) * NB + b) * SEQ + t0 + t8; const LAS float* sp = (const LAS float*)lds + r * 4160 + cl * 65 + t8;
          u32x4 w; w.x = pk2(sp[0], sp[1]); w.y = pk2(sp[2], sp[3]); w.z = pk2(sp[4], sp[5]); w.w = pk2(sp[6], sp[7]); *(u32x4*)o = w; } }
    __syncthreads();
}
__device__ __forceinline__ void hy_post_unit(const bf16_t* HY, const bf16_t* VT, bf16_t* HYO, const float* hb, int unit, LAS unsigned char* lds, int tid) {
    const LAS float* cwl = (const LAS float*)(lds + LDS_CW_OFF);
    LAS float* T = (LAS float*)lds;
    const int ct = unit & 7, tt = (unit >> 3) & 127, b = unit >> 10, t0 = tt * 64, c0 = ct * 64;
    { const int cl = tid >> 3, t8 = (tid & 7) * 8; const bf16_t* o = VT + ((size_t)(c0 + cl) * NB + b) * SEQ + t0 + t8; LAS float* s = T + cl * 65 + t8;
      const u32x4 a = *(const u32x4*)o; s[0] = bflo(a.x); s[1] = bfhi(a.x); s[2] = bflo(a.y); s[3] = bfhi(a.y); s[4] = bflo(a.z); s[5] = bfhi(a.z); s[6] = bflo(a.w); s[7] = bfhi(a.w); }
    __syncthreads();
    { const int tl = tid >> 3, c8 = (tid & 7) * 8; const bf16_t* hy0 = HY + (size_t)b * SEQ * HYP;
      const SC8 x0 = short_conv8(hy0, t0 + tl, SEQ, c0 + c8, cwl), x1 = short_conv8(hy0, t0 + tl, SEQ, 512 + c0 + c8, cwl), vv = short_conv8(hy0, t0 + tl, SEQ, 1024 + c0 + c8, cwl);
      float r[8]; const f32x4 hba = *(const f32x4*)(hb + c0 + c8), hbb = *(const f32x4*)(hb + c0 + c8 + 4);
#pragma unroll
      for (int e = 0; e < 8; ++e) { const float vx = x1.v[e] * vv.v[e]; r[e] = (T[(c8 + e) * 65 + tl] + vx * (e < 4 ? hba[e & 3] : hbb[e & 3])) * x0.v[e]; }
      u32x4 w; w.x = pk2(r[0], r[1]); w.y = pk2(r[2], r[3]); w.z = pk2(r[4], r[5]); w.w = pk2(r[6], r[7]);
      *(u32x4*)(HYO + ((size_t)b * SEQ + t0 + tl) * HYW + c0 + c8) = w; }
    __syncthreads();
}
__device__ __forceinline__ void hy_ctx_unit(const bf16_t* HY, const float* FC, bf16_t* HYO, const float* hb, int unit, LAS unsigned char* lds, int tid) {
    const LAS float* cwl = (const LAS float*)(lds + LDS_CW_OFF);
    LAS float* VX = (LAS float*)lds;
    const int ct = unit & 31, b = unit >> 5, c0 = ct * 16; const bf16_t* hy0 = HY + (size_t)(MLAT + b * CTXL) * HYP;
    { const int s = tid >> 1, c8 = (tid & 1) * 8; const SC8 x1 = short_conv8(hy0, s, CTXL, 512 + c0 + c8, cwl), vv = short_conv8(hy0, s, CTXL, 1024 + c0 + c8, cwl);
#pragma unroll
      for (int e = 0; e < 8; ++e) VX[s * 16 + c8 + e] = x1.v[e] * vv.v[e]; }
    __syncthreads();
    { const int c = tid & 15, tg = tid >> 4; const float* fcf = FC + c0 + c; const float* fcb = FC + 512 + c0 + c;
      for (int t = tg * 8; t < tg * 8 + 8; ++t) {
          float acc = 0.f;
          for (int s = 0; s <= t; ++s) acc += fcf[(size_t)(t - s) * 1024] * VX[s * 16 + c];
          for (int s = t + 1; s < CTXL; ++s) acc += fcb[(size_t)(s - t) * 1024] * VX[s * 16 + c];
          const int col = c0 + c; const bf16_t* hr = hy0 + (size_t)t * HYP + col;
          const float um = t > 0 ? bflo((unsigned)hr[-HYP]) : 0.f, u0 = bflo((unsigned)hr[0]), up = t + 1 < CTXL ? bflo((unsigned)hr[HYP]) : 0.f;
          const float x0 = um * cwl[col] + u0 * cwl[HYP + col] + up * cwl[2 * HYP + col] + cwl[3 * HYP + col];
          HYO[((size_t)MLAT + b * CTXL + t) * HYW + col] = (bf16_t)f2bf((acc + VX[t * 16 + c] * hb[col]) * x0);
      } }
    __syncthreads();
}
__device__ __forceinline__ f32x4 ld4row(const float* p) { return *(const f32x4*)p; }
__device__ __forceinline__ f32x4 ld4row(const bf16_t* p) { const u32x2 w = *(const u32x2*)p; return (f32x4){bflo(w.x), bfhi(w.x), bflo(w.y), bfhi(w.y)}; }
template <bool SRCBF> __device__ __forceinline__ const void* norm_row_ptr(const float* lat, const float* ctxp, const bf16_t* XS, int m) {
    if (SRCBF) return XS + (size_t)m * DM;
    return m < MLAT ? lat + (size_t)m * DM : ctxp + (size_t)(m - MLAT) * DM;
}
template <bool SRCBF> __device__ __forceinline__ void norm_row_load(const void* p, int lane, f32x4 (&v)[4]) {
#pragma unroll
    for (int j = 0; j < 4; ++j) v[j] = SRCBF ? ld4row((const bf16_t*)p + 4 * lane + 256 * j) : ld4row((const float*)p + 4 * lane + 256 * j);
}
template <bool SRCBF> __device__ __forceinline__ void norm_mod_rows(const float* lat, const float* ctxp, const bf16_t* XS, int nrows, const float* gain, const float* shift, const float* scale, bf16_t* H, int gw, int NGW, int lane) {
    const int rpw = (nrows + NGW - 1) / NGW, r0 = gw * rpw, r1 = (r0 + rpw < nrows) ? r0 + rpw : nrows;
    int cb = -1; f32x4 gm[4], shv[4];
    for (int m0 = r0; m0 < r1; m0 += 2) {
        const int m1 = m0 + 1; const bool has1 = m1 < r1; const int m1c = has1 ? m1 : m0;
        f32x4 v0[4], v1[4];
        if (SRCBF) {
#pragma unroll
            for (int j = 0; j < 4; ++j) { v0[j] = ld4row(XS + (size_t)m0 * DM + 4 * lane + 256 * j); v1[j] = ld4row(XS + (size_t)m1c * DM + 4 * lane + 256 * j); }
        } else {
            const float* src0 = m0 < MLAT ? lat + (size_t)m0 * DM : ctxp + (size_t)(m0 - MLAT) * DM; const float* src1 = m1c < MLAT ? lat + (size_t)m1c * DM : ctxp + (size_t)(m1c - MLAT) * DM;
#pragma unroll
            for (int j = 0; j < 4; ++j) { v0[j] = ld4row(src0 + 4 * lane + 256 * j); v1[j] = ld4row(src1 + 4 * lane + 256 * j); }
        }
#pragma unroll
        for (int r = 0; r < 2; ++r) {
            if (r == 1 && !has1) break;
            const int m = r ? m1 : m0; const int bidx = m < MLAT ? (m >> 13) : 8;
            if (bidx != cb) { cb = bidx;
#pragma unroll
                for (int j = 0; j < 4; ++j) { const int col = 4 * lane + 256 * j; gm[j] = *(const f32x4*)(gain + col) * (*(const f32x4*)(scale + (size_t)bidx * NMODV + col) + 1.f); shv[j] = *(const f32x4*)(shift + (size_t)bidx * NMODV + col); } }
            float ss = 0.f;
#pragma unroll
            for (int j = 0; j < 4; ++j) { const f32x4 v = r ? v1[j] : v0[j]; ss += (v[0] * v[0] + v[1] * v[1]) + (v[2] * v[2] + v[3] * v[3]); }
            const float rstd = __builtin_amdgcn_rsqf(wave_sum(ss, lane) * (1.f / DM) + EPS);
#pragma unroll
            for (int j = 0; j < 4; ++j) { const f32x4 v = r ? v1[j] : v0[j]; const int col = 4 * lane + 256 * j;
                const f32x4 y = v * rstd * gm[j] + shv[j]; u32x2 w; w.x = pk2(y[0], y[1]); w.y = pk2(y[2], y[3]); *(u32x2*)(H + (size_t)m * DM + col) = w; }
        }
    }
}
__device__ __forceinline__ void final_norm_rows(const bf16_t* XS, float* X, const float* gain, int gw, int NGW, int lane) {
    const int rpw = (MLAT + NGW - 1) / NGW, r0 = gw * rpw, r1 = (r0 + rpw < MLAT) ? r0 + rpw : MLAT;
    f32x4 gv[4];
#pragma unroll
    for (int j = 0; j < 4; ++j) gv[j] = *(const f32x4*)(gain + 4 * lane + 256 * j);
    for (int m0 = r0; m0 < r1; m0 += 2) {
        const int m1 = m0 + 1; const bool has1 = m1 < r1; const int m1c = has1 ? m1 : m0;
        f32x4 v0[4], v1[4];
#pragma unroll
        for (int j = 0; j < 4; ++j) { v0[j] = ld4row(XS + (size_t)m0 * DM + 4 * lane + 256 * j); v1[j] = ld4row(XS + (size_t)m1c * DM + 4 * lane + 256 * j); }
#pragma unroll
        for (int r = 0; r < 2; ++r) {
            if (r == 1 && !has1) break;
            float* dst = X + (size_t)(r ? m1 : m0) * DM; float ss = 0.f;
#pragma unroll
            for (int j = 0; j < 4; ++j) { const f32x4 v = r ? v1[j] : v0[j]; ss += (v[0] * v[0] + v[1] * v[1]) + (v[2] * v[2] + v[3] * v[3]); }
            const float rstd = __builtin_amdgcn_rsqf(wave_sum(ss, lane) * (1.f / DM) + EPS);
#pragma unroll
            for (int j = 0; j < 4; ++j) { const f32x4 v = r ? v1[j] : v0[j]; *(f32x4*)(dst + 4 * lane + 256 * j) = v * rstd * gv[j]; }
        }
    }
}
__device__ __forceinline__ bf16_t* qk_item_ptr(bf16_t* Q, bf16_t* Kp, long it, int l16, int& m, int& hr) {
    m = (int)(it >> 1); hr = 8 + (int)(it & 1);
    const size_t krow = m < MLAT ? (size_t)(m >> 13) * KEYS + CTXL + (m & 8191) : (size_t)((m - MLAT) >> 8) * KEYS + ((m - MLAT) & 255);
    return Kp + krow * 256 + (hr - 8) * 128 + l16 * 8;
}
__device__ __forceinline__ void qk_rows(bf16_t* Q, bf16_t* Kp, const float* qg, const float* kg, const f32x2* rope, int gw, int NGW, int lane) {
    const int l16 = lane & 15, sub = lane >> 4; const long total = (long)MALL * 2, step = (long)NGW * 4;
    const f32x4 kga = *(const f32x4*)(kg + l16 * 8), kgb = *(const f32x4*)(kg + l16 * 8 + 4); (void)qg;
    for (long it0 = (long)gw * 4 + sub; it0 < total; it0 += 4 * step) {
        bf16_t* ptr[4]; int mm[4], hh[4]; u32x4 w[4];
#pragma unroll
        for (int r = 0; r < 4; ++r) { const long it = it0 + r * step; const long itc = it < total ? it : it0; ptr[r] = qk_item_ptr(Q, Kp, itc, l16, mm[r], hh[r]); w[r] = *(const u32x4*)ptr[r]; }
#pragma unroll
        for (int r = 0; r < 4; ++r) {
            const bool valid = (it0 + r * step) < total;
            const int m = mm[r]; const bool lat = m < MLAT;
            float v[8];
#pragma unroll
            for (int e = 0; e < 4; ++e) { v[2 * e] = bflo(w[r][e]); v[2 * e + 1] = bfhi(w[r][e]); }
            float ss = 0.f;
#pragma unroll
            for (int e = 0; e < 8; ++e) ss += v[e] * v[e];
            ss += shx(ss, 1, lane); ss += shx(ss, 2, lane); ss += shx(ss, 4, lane); ss += shx(ss, 8, lane);
            const float rstd = __builtin_amdgcn_rsqf(ss * (1.f / 128.f) + EPS);
#pragma unroll
            for (int e = 0; e < 8; ++e) v[e] = v[e] * rstd * (e < 4 ? kga[e & 3] : kgb[e & 3]);
            if (lat) { const f32x2* rp = rope + (size_t)(m & 8191) * 64 + l16 * 4;
#pragma unroll
                for (int e = 0; e < 4; ++e) { const f32x2 cs = rp[e]; const float a = v[2 * e], b = v[2 * e + 1]; v[2 * e] = a * cs.x - b * cs.y; v[2 * e + 1] = a * cs.y + b * cs.x; } }
            u32x4 o; o.x = pk2(v[0], v[1]); o.y = pk2(v[2], v[3]); o.z = pk2(v[4], v[5]); o.w = pk2(v[6], v[7]);
            if (valid) *(u32x4*)ptr[r] = o;
        }
    }
}
#define GEMM_RUN(EPI, Aptr, Btptr, Mrows, Ncols, Kdim, Eobj) do { pg8::Gemm g_{(const pg8::bf16_t*)(Aptr), (const pg8::bf16_t*)(Btptr), (Mrows), (Ncols), (Kdim)}; pg8::StaticOrder S_; S_.init((Mrows), (Ncols), G, bid); \
    pg8::gemm_phase<EPI, pg8::StaticOrder, true, true>(lds, g_, S_, (Eobj), tid); } while (0)

__device__ __forceinline__ Params kparams() {
#if defined(__HIP_DEVICE_COMPILE__)
    auto q = __builtin_amdgcn_kernarg_segment_ptr(); asm volatile("" : "+s"(q)); return *(const __attribute__((address_space(4))) Params*)q;
#else
    return Params{};
#endif
}
#define PH_BEGIN() const Params p = kparams(); unsigned char* ws = p.ws; (void)ws
__global__ void __launch_bounds__(512, 2) fwd_megakernel(Params p_unused) {
    extern __shared__ __attribute__((aligned(16))) unsigned char smem[];
    cg::grid_group grid = cg::this_grid();
    LAS unsigned char* lds = (LAS unsigned char*)smem;
    const int wave0 = __builtin_amdgcn_readfirstlane((int)threadIdx.x >> 6);
    unsigned xcc_id;
    { const int t0_ = (wave0 << 6) | lane_fresh();
      if (t0_ < 2) ((volatile LAS unsigned*)(lds + LDS_CTL_OFF))[t0_] = 0u;
      for (int k = t0_; k < 2048; k += 512) { float sn, cs; sincospif((float)k * (1.f / 8192.f), &sn, &cs); ((LAS f32x2*)(lds + LDS_TW_OFF))[k] = (f32x2){cs, -sn}; }
      if (blockIdx.x == 0) for (int k = t0_; k < (int)(WS_BAR_BYTES / 4); k += 512) __hip_atomic_store((unsigned*)(kparams().ws + WS_BAR) + k, 0u, __ATOMIC_RELAXED, __HIP_MEMORY_SCOPE_AGENT);
      __syncthreads();
      xcc_id = xb_xcc_id(); }
#define GRID_BAR() do { XcdBarrier b_; b_.tid = (wave0 << 6) | lane_fresh(); b_.bar = (unsigned*)(kparams().ws + WS_BAR); b_.x = xcc_id; b_.st = (volatile LAS unsigned*)(lds + LDS_CTL_OFF); xcd_barrier(b_); } while (0)
#define TID_VARS() const int lane = lane_fresh(), tid = (wave0 << 6) | lane, wave = wave0; int G = gridDim.x, bid = blockIdx.x; asm volatile("" : "+s"(G), "+s"(bid)); const int gw = bid * 8 + wave, NGW = G * 8; (void)lane; (void)gw; (void)NGW
    { PH_BEGIN(); TID_VARS();
      phase_weights(p, lds, gw, NGW, wave, lane);
      __syncthreads(); }
    { PH_BEGIN(); TID_VARS();
      for (int u = bid; u < 192; u += G) mod_unit(p, u, lds, tid); }
    { PH_BEGIN(); TID_VARS(); float* filtT = (float*)(ws + WS_FILT); float* filtC = (float*)(ws + WS_FILTC);
      for (int u = bid; u < 2 * 512 + 16; u += G) {
        if (u < 1024) filter_unit(p, u >> 9, SEQ, (u & 511) * 16, filtT + (size_t)(u >> 9) * 1024 * SEQ, true, lds, tid);
        else filter_unit(p, 0, CTXL, (u - 1024) * 16, filtC, false, lds, tid);
      } }
    { PH_BEGIN(); TID_VARS(); f32x2* rope = (f32x2*)(ws + WS_ROPE);
      for (int e = bid * 512 + tid; e < SEQ * 64; e += G * 512) { const int t = e >> 6, i = e & 63; const float pos = (float)(i < 32 ? (t >> 6) : (t & 63));
        const float inv = powf(10000.f, -(float)(2 * (i & 31)) * (1.f / 64.f)); float s, c; sincosf(pos * inv, &s, &c); rope[e] = (f32x2){c, s}; } }
    grid.sync();
    if (((wave0 << 6) | lane_fresh()) == 0) { unsigned nloc, nx; (void)xb_add((unsigned*)(kparams().ws + WS_BAR) + XB_XCNT(xcc_id), 1u); xcd_barrier_complete((unsigned*)(kparams().ws + WS_BAR), xcc_id, nloc, nx); ((volatile LAS unsigned*)(lds + LDS_CTL_OFF))[0] = nloc; ((volatile LAS unsigned*)(lds + LDS_CTL_OFF))[1] = nx; }
    __syncthreads();

    for (int l = 0; l < DEPTH; ++l) {
        asm volatile("" : "+s"(l));
        { PH_BEGIN(); TID_VARS(); const float* modl = (const float*)(ws + WS_MOD) + (size_t)l * 9 * NMODV;
          if (l == 0) for (int c = bid; c < HYW; c += G) kf_unit((const float*)(ws + WS_FILT) + (size_t)l * 1024 * SEQ, (f32x2*)(ws + WS_KF), c, lds, tid);
          if (l == 0) norm_mod_rows<false>(p.x, p.ctx, nullptr, MALL, p.norm_mix + l * DM, modl + 0 * DM, modl + 1 * DM, (bf16_t*)(ws + WS_H), gw, NGW, lane);
          else norm_mod_rows<true>(nullptr, nullptr, (const bf16_t*)(ws + WS_XS), MALL, p.norm_mix + l * DM, modl + 0 * DM, modl + 1 * DM, (bf16_t*)(ws + WS_H), gw, NGW, lane); }
        GRID_BAR();
        { PH_BEGIN(); TID_VARS(); const unsigned char* wb = ws + WS_W + (size_t)l * WL_STRIDE;
          pg8::EpiIn E{(bf16_t*)(ws + WS_Q), (bf16_t*)(ws + WS_K), (bf16_t*)(ws + WS_V), (bf16_t*)(ws + WS_HY), (bf16_t*)p.out, (bf16_t*)(ws + WS_G)}; GEMM_RUN(pg8::EpiIn, ws + WS_H, wb + WL_IN, MALL, PROJ, DM, E); }
        GRID_BAR();
        { PH_BEGIN(); TID_VARS();
          qk_rows((bf16_t*)(ws + WS_Q), (bf16_t*)(ws + WS_K), p.q_norm + l * 128, p.k_norm + l * 128, (const f32x2*)(ws + WS_ROPE), gw, NGW, lane);
          stage_conv_weights(p.conv_w + (size_t)l * 3 * HYP, p.conv_b + (size_t)l * HYP, lds, tid);
          for (int u = bid; u < NB * 128 * 4; u += G) hy_pre_unit((const bf16_t*)(ws + WS_HY), (bf16_t*)(ws + WS_H), u, lds, tid); }
        GRID_BAR();
        { PH_BEGIN(); TID_VARS();
          const attn::bf16* Qa = (const attn::bf16*)(ws + WS_Q); const attn::bf16* Ka = (const attn::bf16*)(ws + WS_K); const attn::bf16* Va = (const attn::bf16*)(ws + WS_V);
          for (int i = 0; bid + i * G < 2048; ++i) {
            int u = bid + i * G;
            if (G == 256) { const int xcd = bid & 7, j = bid >> 3; u = ((xcd * 2 + (i >> 2)) << 7) + ((i & 3) << 5) + j; }
            const int qb = u & 31, g4 = (u >> 5) & 3, kvh = (u >> 7) & 1, b = u >> 8, h = kvh * 4 + g4;
            const attn::bf16* Qp = Qa + ((size_t)b * SEQ + qb * 256) * DM + h * 128;
            attn::attn_dense_body<attn::bf16>(Qp, Ka + (size_t)b * KEYS * 256 + kvh * 128, Va + (size_t)b * KEYS * 256 + kvh * 128, (attn::bf16*)Qp, KEYS, (char*)smem, (wave0 << 6) | lane_fresh(), p.q_norm + l * 128, (const f32x2*)(ws + WS_ROPE) + (size_t)qb * 256 * 64);
            __syncthreads();
          }
          if (l == 0) for (int u = bid; u < 64; u += G) {
            const int h = u & 7, b = u >> 3, kvh = h >> 2;
            const attn::bf16* Qp = Qa + ((size_t)MLAT + b * CTXL) * DM + h * 128;
            attn::attn_dense_body<attn::bf16>(Qp, Ka + (size_t)b * KEYS * 256 + kvh * 128, Va + (size_t)b * KEYS * 256 + kvh * 128, (attn::bf16*)Qp, CTXL, (char*)smem, (wave0 << 6) | lane_fresh(), p.q_norm + l * 128, (const f32x2*)nullptr);
            __syncthreads();
          } }
        { PH_BEGIN(); TID_VARS();
          fftconv_units((bf16_t*)(ws + WS_H), (const f32x2*)(ws + WS_KF), HYW * 4, bid, G, lds, tid); }
        GRID_BAR();
        { PH_BEGIN(); TID_VARS();
          stage_conv_weights(p.conv_w + (size_t)l * 3 * HYP, p.conv_b + (size_t)l * HYP, lds, tid);
          for (int u = bid; u < NB * 128 * 8; u += G) hy_post_unit((const bf16_t*)(ws + WS_HY), (const bf16_t*)(ws + WS_H), (bf16_t*)(ws + WS_HYO), p.hbias + (size_t)l * HYW, u, lds, tid);
          if (l == 0) for (int u = bid; u < 256; u += G) hy_ctx_unit((const bf16_t*)(ws + WS_HY), (const float*)(ws + WS_FILTC), (bf16_t*)(ws + WS_HYO), p.hbias + (size_t)l * HYW, u, lds, tid); }
        GRID_BAR();
        { PH_BEGIN(); TID_VARS(); const unsigned char* wb = ws + WS_W + (size_t)l * WL_STRIDE; const int Mmix = (l == DEPTH - 1) ? MLAT : MALL;
          pg8::EpiMerge<false> E{(const bf16_t*)p.out, (const bf16_t*)(ws + WS_G), (bf16_t*)(ws + WS_HY), 0}; GEMM_RUN(pg8::EpiMerge<false>, ws + WS_Q, wb + WL_OA, Mmix, DM, DM, E); }
        { PH_BEGIN(); TID_VARS(); const unsigned char* wb = ws + WS_W + (size_t)l * WL_STRIDE; const int Mmix = (l == DEPTH - 1) ? MLAT : MALL;
          pg8::EpiMerge<true> E{(const bf16_t*)p.out, (const bf16_t*)(ws + WS_G), (bf16_t*)(ws + WS_HY), DM}; GEMM_RUN(pg8::EpiMerge<true>, ws + WS_HYO, wb + WL_OH, Mmix, DM, HYW, E); }
        GRID_BAR();
        { PH_BEGIN(); TID_VARS(); const unsigned char* wb = ws + WS_W + (size_t)l * WL_STRIDE; const int Mmix = (l == DEPTH - 1) ? MLAT : MALL; const float* modl = (const float*)(ws + WS_MOD) + (size_t)l * 9 * NMODV;
          if (l == 0) { pg8::EpiResid<true> E{p.x, p.ctx, (bf16_t*)(ws + WS_XS), modl + 2 * DM}; GEMM_RUN(pg8::EpiResid<true>, ws + WS_HY, wb + WL_OUT, Mmix, DM, DM, E); }
          else { pg8::EpiResid<false> E{nullptr, nullptr, (bf16_t*)(ws + WS_XS), modl + 2 * DM}; GEMM_RUN(pg8::EpiResid<false>, ws + WS_HY, wb + WL_OUT, Mmix, DM, DM, E); } }
        GRID_BAR();
        { PH_BEGIN(); TID_VARS(); const int Mmix = (l == DEPTH - 1) ? MLAT : MALL; const float* modl = (const float*)(ws + WS_MOD) + (size_t)l * 9 * NMODV;
          norm_mod_rows<true>(nullptr, nullptr, (const bf16_t*)(ws + WS_XS), Mmix, p.norm_ffn + l * DM, modl + 3 * DM, modl + 4 * DM, (bf16_t*)(ws + WS_H), gw, NGW, lane); }
        GRID_BAR();
        { PH_BEGIN(); TID_VARS(); const unsigned char* wb = ws + WS_W + (size_t)l * WL_STRIDE; const int Mmix = (l == DEPTH - 1) ? MLAT : MALL;
          pg8::EpiSwiglu E{(bf16_t*)(ws + WS_ACT)}; GEMM_RUN(pg8::EpiSwiglu, ws + WS_H, wb + WL_GU, Mmix, 2 * DFF, DM, E); }
        GRID_BAR();
        { PH_BEGIN(); TID_VARS(); const unsigned char* wb = ws + WS_W + (size_t)l * WL_STRIDE; const int Mmix = (l == DEPTH - 1) ? MLAT : MALL; const float* modl = (const float*)(ws + WS_MOD) + (size_t)l * 9 * NMODV;
          pg8::EpiResid<false> E{nullptr, nullptr, (bf16_t*)(ws + WS_XS), modl + 5 * DM}; GEMM_RUN(pg8::EpiResid<false>, ws + WS_ACT, wb + WL_DN, Mmix, DM, DFF, E);
          if (l == 0) { const int nwg = (MALL / 256) * (DM / 256), first = (nwg % G) ? nwg % G : 0;
            if (bid >= first) { __syncthreads(); for (int c = bid - first; c < HYW; c += G - first) kf_unit((const float*)(ws + WS_FILT) + (size_t)1024 * SEQ, (f32x2*)(ws + WS_KF), c, lds, tid); } } }
        GRID_BAR();
    }
    { PH_BEGIN(); TID_VARS();
      final_norm_rows((const bf16_t*)(ws + WS_XS), p.out, p.norm_final, gw, NGW, lane); }
}

extern "C" void kernel_launch(void* const* d_in, const int* in_sizes, int n_in, void* d_out, int out_size, void* d_ws, size_t ws_size, hipStream_t stream) {
    static int grid_blocks = 0;
    if (grid_blocks == 0) {
        if (n_in != 28 || in_sizes[0] != MLAT * DM || out_size != MLAT * DM || ws_size < WS_END) {
            fprintf(stderr, "kernel_launch: shape/workspace mismatch: n_in %d in0 %d out %d ws %zu (need >= %zu)\n", n_in, n_in > 0 ? in_sizes[0] : -1, out_size, ws_size, (size_t)WS_END); grid_blocks = -1; return; }
        int dev = 0, cus = 0, per_cu = 0;
        hipGetDevice(&dev); hipDeviceGetAttribute(&cus, hipDeviceAttributeMultiprocessorCount, dev);
        if (hipFuncSetAttribute((const void*)fwd_megakernel, hipFuncAttributeMaxDynamicSharedMemorySize, LDS_BYTES) != hipSuccess) { fprintf(stderr, "kernel_launch: hipFuncSetAttribute failed\n"); grid_blocks = -1; return; }
        if (hipOccupancyMaxActiveBlocksPerMultiprocessor(&per_cu, (const void*)fwd_megakernel, 512, LDS_BYTES) != hipSuccess || per_cu < 1) { fprintf(stderr, "kernel_launch: occupancy query says %d\n", per_cu); per_cu = 1; }
        (void)hipGetLastError();
        grid_blocks = cus * 1;
    }
    if (grid_blocks < 0) return;
    Params p{};
    const float** pp = (const float**)&p;
    for (int i = 0; i < 28; ++i) pp[i] = (const float*)d_in[i];
    p.out = (float*)d_out; p.ws = (unsigned char*)d_ws;
    void* args[] = {&p};
    hipError_t e = hipLaunchCooperativeKernel((const void*)fwd_megakernel, dim3(grid_blocks), dim3(512), args, LDS_BYTES, stream);
    if (e != hipSuccess) fprintf(stderr, "cooperative launch failed: %s (grid %d)\n", hipGetErrorString(e), grid_blocks);
}
```

```cpp
#include <hip/hip_runtime.h>
#include <hip/hip_bf16.h>
#include <hip/hip_cooperative_groups.h>
#include <cstdio>
#include <cstdint>
namespace cg = cooperative_groups;

constexpr int DM = 1024, NB = 8, SEQ = 8192, CTXL = 256, DEPTH = 2;
constexpr int MLAT = NB * SEQ, MCTX = NB * CTXL, MALL = MLAT + MCTX;
constexpr int PROJ = 5120, DFF = 2816, HYW = 512, HYP = 1536, GATEW = 2048, NMODV = 6 * DM;
constexpr int KEYS = CTXL + SEQ;
constexpr int NFFT = 16384;
constexpr float EPS = 1e-6f;
constexpr size_t MiB = 1u << 20;
constexpr size_t WS_MOD = 0;
constexpr size_t WS_TW = 512 * 1024;
constexpr size_t WS_ROPE = 1 * MiB;
constexpr size_t WS_W = 6 * MiB;
constexpr size_t WL_IN = 0, WL_OA = WL_IN + (size_t)PROJ * DM * 2, WL_OH = WL_OA + (size_t)DM * DM * 2, WL_OUT = WL_OH + (size_t)DM * HYW * 2,
                 WL_GU = WL_OUT + (size_t)DM * DM * 2, WL_DN = WL_GU + (size_t)2 * DFF * DM * 2, WL_STRIDE = WL_DN + (size_t)DM * DFF * 2;
constexpr size_t WS_KF = 70 * MiB;
constexpr size_t WS_H = 134 * MiB;
constexpr size_t WS_Q = 266 * MiB;
constexpr size_t WS_K = 398 * MiB;
constexpr size_t WS_V = 431 * MiB;
constexpr size_t WS_HYO = 398 * MiB;
constexpr size_t WS_HY = 464 * MiB;
constexpr size_t WS_G = 662 * MiB;
constexpr size_t WS_XS = 670 * MiB;
constexpr size_t WS_ACT = 266 * MiB;
constexpr size_t WS_CTXS = 926 * MiB;
constexpr size_t WS_FILT = 934 * MiB;
constexpr size_t WS_FILTC = 998 * MiB;
constexpr size_t WS_END = 1000 * MiB;
static_assert(WS_W + 2 * WL_STRIDE <= WS_KF && WS_H + (size_t)MALL * DM * 2 <= WS_Q && WS_Q + (size_t)MALL * DM * 2 <= WS_K && WS_K + (size_t)NB * KEYS * 256 * 2 <= WS_V &&
              WS_V + (size_t)NB * KEYS * 256 * 2 <= WS_HY && WS_HYO + (size_t)MALL * HYW * 2 <= WS_HY && WS_HY + (size_t)MALL * HYP * 2 <= WS_G && WS_G + (size_t)MCTX * GATEW * 2 <= WS_XS && WS_XS + (size_t)MALL * DM * 2 <= WS_CTXS && (size_t)MLAT * GATEW * 2 <= (size_t)MLAT * DM * 4 &&
              WS_ACT + (size_t)MALL * DFF * 2 <= WS_G && (size_t)HYW * NB * SEQ * 4 <= (size_t)MALL * DM * 2, "ws map");

#define LAS __attribute__((address_space(3)))
typedef float f32x4 __attribute__((ext_vector_type(4)));
typedef float f32x2 __attribute__((ext_vector_type(2)));
typedef unsigned u32x4 __attribute__((ext_vector_type(4)));
typedef unsigned u32x2 __attribute__((ext_vector_type(2)));
typedef unsigned short bf16_t;
constexpr int LDS_BYTES = 159744;
constexpr int LDS_TW_OFF = 139264;
constexpr int LDS_CTL_OFF = 155648;
constexpr size_t WS_BAR = 480 * 1024, WS_BAR_BYTES = 16384;

struct Params {
    const float *x, *c, *ctx, *c_ctx, *w_mod, *b_mod, *norm_mix, *w_in, *q_norm, *k_norm, *conv_w, *conv_b, *fw1, *fb1, *fw2, *fb2, *fw3, *fb3, *fw4, *freq, *hbias,
                *w_oa, *w_oh, *w_out, *norm_ffn, *w_gu, *w_dn, *norm_final;
    float* out; unsigned char* ws;
};

__device__ __forceinline__ unsigned f2bf(float f) { unsigned u = __builtin_bit_cast(unsigned, f); return (u + 0x7fffu + ((u >> 16) & 1u)) >> 16; }
__device__ __forceinline__ unsigned pk2(float lo, float hi) { unsigned r; asm("v_cvt_pk_bf16_f32 %0, %1, %2" : "=v"(r) : "v"(lo), "v"(hi)); return r; }
__device__ __forceinline__ float bflo(unsigned w) { return __builtin_bit_cast(float, w << 16); }
__device__ __forceinline__ float bfhi(unsigned w) { return __builtin_bit_cast(float, w & 0xffff0000u); }
__device__ __forceinline__ float shx(float v, int o, int lane) { return __builtin_bit_cast(float, __builtin_amdgcn_ds_bpermute((lane ^ o) << 2, __builtin_bit_cast(int, v))); }
__device__ __forceinline__ float wave_sum(float v, int lane) {
#pragma unroll
    for (int o = 1; o < 64; o <<= 1) v += shx(v, o, lane);
    return v;
}
__device__ __forceinline__ float sigmoidf_(float v) { return __builtin_amdgcn_rcpf(1.f + __expf(-v)); }
__device__ __forceinline__ int lane_fresh() { int t; asm volatile("v_mbcnt_lo_u32_b32 %0, -1, 0\n\tv_mbcnt_hi_u32_b32 %0, -1, %0" : "=v"(t)); return t; }
namespace pg8 {
#define PG8_LAS __attribute__((address_space(3)))
typedef unsigned short bf16_t;
typedef short bf16x8 __attribute__((ext_vector_type(8)));
typedef float f32x4 __attribute__((ext_vector_type(4)));
typedef unsigned u32x4 __attribute__((ext_vector_type(4)));
constexpr int BM = 256, BK = 64, HALF = 128, HTB = HALF * BK * 2  , STAGE_BYTES = 8 * HTB, NXCD = 8, WGM = 8;

__host__ __device__ __forceinline__ int lds_byte(int r, int c) { const int st = (r >> 4) * 2 + (c >> 5), rr = r & 15, cc = c & 31, ob = rr * 64 + cc * 2; return st * 1024 + (ob ^ (((ob >> 9) & 1) << 5)); }
__host__ __device__ __forceinline__ void stage_rc(int b, int& R, int& C) { const int st = b / 1024, sb = b % 1024, swz = sb ^ (((sb >> 9) & 1) << 5); R = (st >> 1) * 16 + swz / 64; C = (st & 1) * 32 + (swz % 64) / 2; }
__host__ __device__ __forceinline__ int perm32(int rho) { const int n = rho >> 4, i = rho & 15; return 8 * (i >> 2) + 4 * n + (i & 3); }

struct Unit { int pm, pn; };
struct Gemm { const bf16_t* A; const bf16_t* Bt; int M, N, K; };

struct StaticOrder {
    int nM, nN, nwg, G, c;
    __host__ __device__ void init(int M, int N, int G_, int c_) { nM = M / BM; nN = N / BM; nwg = nM * nN; G = G_; c = c_; }
    __host__ __device__ bool next(int i, Unit& u) const {
        const long L = (long)i * G + c; if (L >= nwg) return false;
        int wgid = (int)L; { const int q = nwg / NXCD, r = nwg % NXCD, xcd = wgid % NXCD, off = wgid / NXCD; wgid = (xcd < r ? xcd * (q + 1) : r * (q + 1) + (xcd - r) * q) + off; }
        const int nig = WGM * nN, gid = wgid / nig, fm = gid * WGM, gsz = (nM - fm) < WGM ? (nM - fm) : WGM;
        u.pm = fm + ((wgid % nig) % gsz); u.pn = (wgid % nig) / gsz; return true;
    }
    __device__ __forceinline__ void a_ready(const Unit&) const {}
    __device__ __forceinline__ void done(const Unit&) const {}
};

__device__ __forceinline__ unsigned cvt_pk_bf16(float lo, float hi) { unsigned r; asm volatile("v_cvt_pk_bf16_f32 %0, %1, %2" : "=v"(r) : "v"(lo), "v"(hi)); return r; }
typedef float f32x2 __attribute__((ext_vector_type(2)));
template <class Epi, class Sched, bool ALIGN_EPI = false, bool SP2 = false>
__device__ __forceinline__ void gemm_phase(PG8_LAS unsigned char* lds, const Gemm g, const Sched& S, const Epi& E, const int tid_in) {
    const int tid = tid_in, wid = __builtin_amdgcn_readfirstlane(tid >> 6), lane = tid & 63, wr = wid >> 2, wc = wid & 3, fr = lane & 15, fq = lane >> 4;
    const int K = g.K, nt = K / BK;
    unsigned voffA[2], voffB[2];
#pragma unroll
    for (int i = 0; i < 2; ++i) { int R, C; stage_rc(tid * 16 + i * 8192, R, C); const int Rb = Epi::PERM ? ((R & ~31) + perm32(R & 31)) : R;
        voffA[i] = (unsigned)(R * K + C) * 2u; voffB[i] = (unsigned)(Rb * K + C) * 2u; }
    const size_t kstep = (size_t)(BK * 2);
    const size_t hstep = (size_t)HALF * K * 2;
    const size_t tstep = 2 * hstep;
    const unsigned ldsw = (unsigned)wid * 1024u;
    const int aoff = lds_byte(wr * 64 + fr, fq * 8), boff = lds_byte(wc * 32 + fr, fq * 8);
#define PG8_SA(b, h) (((b) * 2 + (h)) * HTB)
#define PG8_SB(b, h) ((4 + (b) * 2 + (h)) * HTB)
#define PG8_STAGE(bufoff, gbase, voff) do { _Pragma("unroll") for (int _i = 0; _i < 2; ++_i) \
        __builtin_amdgcn_global_load_lds((const unsigned*)((const char*)(gbase) + (voff)[_i]), (PG8_LAS unsigned*)(lds + (bufoff) + ldsw + _i * 8192), 16, 0, 0); } while (0)
#define PG8_LDA(dst, b, h) do { _Pragma("unroll") for (int m = 0; m < 4; ++m) _Pragma("unroll") for (int k = 0; k < 2; ++k) dst[m][k] = *(const PG8_LAS bf16x8*)(lds + PG8_SA(b, h) + aoff + m * 2048 + k * 1024); } while (0)
#define PG8_LDB(dst, b, h) do { _Pragma("unroll") for (int n = 0; n < 2; ++n) _Pragma("unroll") for (int k = 0; k < 2; ++k) dst[n][k] = *(const PG8_LAS bf16x8*)(lds + PG8_SB(b, h) + boff + n * 2048 + k * 1024); } while (0)
#define PG8_MMA(ai, bj, At, Bt) do { __builtin_amdgcn_s_setprio(1); _Pragma("unroll") for (int m = 0; m < 4; ++m) _Pragma("unroll") for (int n = 0; n < 2; ++n) _Pragma("unroll") for (int k = 0; k < 2; ++k) \
        acc[ai][bj][m][n] = __builtin_amdgcn_mfma_f32_16x16x32_bf16(Bt[n][k], At[m][k], acc[ai][bj][m][n], 0, 0, 0); __builtin_amdgcn_s_setprio(0); } while (0)
#define PG8_WAIT_V(n) asm volatile("s_waitcnt vmcnt(" #n ")" ::: "memory")
#define PG8_WAIT_L(n) asm volatile("s_waitcnt lgkmcnt(" #n ")" ::: "memory")
#define PG8_BAR __builtin_amdgcn_s_barrier()
#define PG8_SCHED __builtin_amdgcn_sched_barrier(0)
    Unit cur, nxt; int ui = 0;
    if (!S.next(0, cur)) return;
    f32x4 acc[2][2][4][2];
#pragma unroll
    for (int a = 0; a < 2; ++a)
#pragma unroll
        for (int b = 0; b < 2; ++b)
#pragma unroll
            for (int m = 0; m < 4; ++m)
#pragma unroll
                for (int n = 0; n < 2; ++n) acc[a][b][m][n] = (f32x4){0.f, 0.f, 0.f, 0.f};
    bf16x8 At[4][2], B0[2][2], B1[2][2];
    const char* cA = (const char*)g.A + (size_t)cur.pm * tstep; const char* cB = (const char*)g.Bt + (size_t)cur.pn * tstep;
    S.a_ready(cur);
    if constexpr (SP2) {
        PG8_STAGE(PG8_SB(0, 0), cB, voffB); PG8_STAGE(PG8_SB(0, 1), cB + hstep, voffB); PG8_STAGE(PG8_SA(0, 0), cA, voffA); PG8_STAGE(PG8_SA(0, 1), cA + hstep, voffA);
        if (wr == 1) PG8_BAR;
        PG8_WAIT_V(2); PG8_BAR;
        PG8_STAGE(PG8_SB(1, 0), cB + kstep, voffB); PG8_STAGE(PG8_SA(1, 0), cA + kstep, voffA); PG8_STAGE(PG8_SB(1, 1), cB + hstep + kstep, voffB);
        PG8_WAIT_V(6); PG8_BAR;
    } else {
        PG8_STAGE(PG8_SB(0, 0), cB, voffB); PG8_STAGE(PG8_SA(0, 0), cA, voffA); PG8_STAGE(PG8_SB(0, 1), cB + hstep, voffB); PG8_STAGE(PG8_SA(0, 1), cA + hstep, voffA);
        if (wr == 1) PG8_BAR;
        PG8_WAIT_V(4); PG8_BAR;
        PG8_STAGE(PG8_SB(1, 0), cB + kstep, voffB); PG8_STAGE(PG8_SA(1, 0), cA + kstep, voffA); PG8_STAGE(PG8_SB(1, 1), cB + hstep + kstep, voffB);
        PG8_WAIT_V(6); PG8_BAR;
    }
    for (;;) {
        const bool has_next = S.next(ui + 1, nxt);
        const char* nA = has_next ? (const char*)g.A + (size_t)nxt.pm * tstep : cA; const char* nB = has_next ? (const char*)g.Bt + (size_t)nxt.pn * tstep : cB;
        for (int t = 0; t < nt; t += 2) {
            const bool last = (t == nt - 2);
            const char* a1 = cA + (size_t)(t + 1) * kstep;
            const char* a2 = last ? nA : cA + (size_t)(t + 2) * kstep; const char* b2 = last ? nB : cB + (size_t)(t + 2) * kstep;
            const char* a3 = a2 + kstep; const char* b3 = b2 + kstep;
            if (last && has_next) S.a_ready(nxt);
            if constexpr (SP2) {
            PG8_LDB(B0, 0, 0); PG8_LDB(B1, 0, 1); PG8_SCHED; PG8_LDA(At, 0, 0); PG8_STAGE(PG8_SA(1, 1), a1 + hstep, voffA);
            PG8_WAIT_V(8); PG8_WAIT_L(0); PG8_BAR; PG8_MMA(0, 0, At, B0); PG8_MMA(0, 1, At, B1); PG8_BAR; PG8_SCHED;
            PG8_LDA(At, 0, 1); PG8_STAGE(PG8_SB(0, 0), b2, voffB); PG8_STAGE(PG8_SB(0, 1), b2 + hstep, voffB); PG8_STAGE(PG8_SA(0, 0), a2, voffA);
            PG8_WAIT_V(8); PG8_WAIT_L(0); PG8_BAR; PG8_MMA(1, 0, At, B0); PG8_MMA(1, 1, At, B1); PG8_BAR; PG8_SCHED;
            PG8_LDB(B0, 1, 0); PG8_LDB(B1, 1, 1); PG8_SCHED; PG8_LDA(At, 1, 0); PG8_STAGE(PG8_SA(0, 1), a2 + hstep, voffA);
            PG8_WAIT_V(8); PG8_WAIT_L(0); PG8_BAR; PG8_MMA(0, 0, At, B0); PG8_MMA(0, 1, At, B1); PG8_BAR; PG8_SCHED;
            PG8_LDA(At, 1, 1); PG8_STAGE(PG8_SB(1, 0), b3, voffB); PG8_STAGE(PG8_SB(1, 1), b3 + hstep, voffB); PG8_STAGE(PG8_SA(1, 0), a3, voffA);
            PG8_WAIT_V(8); PG8_WAIT_L(0); PG8_BAR; PG8_MMA(1, 0, At, B0); PG8_MMA(1, 1, At, B1); PG8_BAR; PG8_SCHED;
            } else {
            PG8_LDB(B0, 0, 0); PG8_SCHED; PG8_LDA(At, 0, 0); PG8_STAGE(PG8_SA(1, 1), a1 + hstep, voffA);
            PG8_WAIT_L(8); PG8_BAR; PG8_WAIT_L(0); PG8_MMA(0, 0, At, B0); PG8_BAR; PG8_SCHED;
            PG8_LDB(B1, 0, 1); PG8_STAGE(PG8_SB(0, 0), b2, voffB);
            PG8_BAR; PG8_WAIT_L(0); PG8_MMA(0, 1, At, B1); PG8_BAR;
            PG8_LDA(At, 0, 1); PG8_STAGE(PG8_SA(0, 0), a2, voffA);
            PG8_BAR; PG8_WAIT_L(0); PG8_MMA(1, 0, At, B0); PG8_BAR; PG8_SCHED;
            PG8_STAGE(PG8_SB(0, 1), b2 + hstep, voffB);
            PG8_WAIT_V(6); PG8_BAR; PG8_MMA(1, 1, At, B1); PG8_BAR;
            PG8_LDB(B0, 1, 0); PG8_SCHED; PG8_LDA(At, 1, 0); PG8_STAGE(PG8_SA(0, 1), a2 + hstep, voffA);
            PG8_WAIT_L(8); PG8_BAR; PG8_WAIT_L(0); PG8_MMA(0, 0, At, B0); PG8_BAR; PG8_SCHED;
            PG8_LDB(B1, 1, 1); PG8_STAGE(PG8_SB(1, 0), b3, voffB);
            PG8_BAR; PG8_WAIT_L(0); PG8_MMA(0, 1, At, B1); PG8_BAR;
            PG8_LDA(At, 1, 1); PG8_STAGE(PG8_SA(1, 0), a3, voffA);
            PG8_BAR; PG8_WAIT_L(0); PG8_MMA(1, 0, At, B0); PG8_BAR; PG8_SCHED;
            PG8_STAGE(PG8_SB(1, 1), b3 + hstep, voffB);
            PG8_WAIT_V(6); PG8_BAR; PG8_MMA(1, 1, At, B1); PG8_BAR;
            }
        }
        if constexpr (ALIGN_EPI) { if (wr == 0) PG8_BAR; }
        if constexpr (!Epi::AFTER_DRAIN) { E(acc, cur, wr, wc, fr, fq); S.done(cur); }
        if (!has_next) break;
#pragma unroll
        for (int a = 0; a < 2; ++a)
#pragma unroll
            for (int b = 0; b < 2; ++b)
#pragma unroll
                for (int m = 0; m < 4; ++m)
#pragma unroll
                    for (int n = 0; n < 2; ++n) acc[a][b][m][n] = (f32x4){0.f, 0.f, 0.f, 0.f};
        cur = nxt; cA = nA; cB = nB; ++ui;
        if constexpr (ALIGN_EPI) { if (wr == 1) PG8_BAR; }
    }
    PG8_WAIT_V(0);
    if constexpr (!ALIGN_EPI) { if (wr == 0) PG8_BAR; }
    PG8_BAR;
    if constexpr (Epi::AFTER_DRAIN) { E.fused(acc, cur, wr, wc, fr, fq, lds, wid, lane); S.done(cur); }
#undef PG8_SA
#undef PG8_SB
#undef PG8_STAGE
#undef PG8_LDA
#undef PG8_LDB
#undef PG8_MMA
#undef PG8_WAIT_V
#undef PG8_WAIT_L
#undef PG8_BAR
#undef PG8_SCHED
}
}
namespace pg8 {
__device__ __forceinline__ u32x4 pack8(const f32x4 v0, const f32x4 v1) { u32x4 w; w.x = cvt_pk_bf16(v0[0], v0[1]); w.y = cvt_pk_bf16(v0[2], v0[3]); w.z = cvt_pk_bf16(v1[0], v1[1]); w.w = cvt_pk_bf16(v1[2], v1[3]); return w; }
struct EpiIn {
    static constexpr bool PERM = true, AFTER_DRAIN = false;
    bf16_t *Q, *Kp, *Vp, *HY, *Glat, *Gctx;
    __device__ __forceinline__ void operator()(const f32x4 (&acc)[2][2][4][2], const Unit& u, int wr, int wc, int fr, int fq) const {
        const int pn = u.pn, m0 = u.pm * BM; bf16_t* base; int ldc, colt; size_t rowbase = (size_t)m0;
        if (pn < 4) { base = Q; ldc = 1024; colt = pn * 256; }
        else if (pn < 6) { base = (pn == 4) ? Kp : Vp; ldc = 256; colt = 0; rowbase = (m0 < MLAT) ? (size_t)(m0 >> 13) * KEYS + CTXL + (m0 & 8191) : (size_t)((m0 - MLAT) >> 8) * KEYS; }
        else if (pn < 12) { base = HY; ldc = 1536; colt = (pn - 6) * 256; }
        else { const bool lat = m0 < MLAT; base = lat ? Glat : Gctx; ldc = 2048; colt = (pn - 12) * 256; if (!lat) rowbase = (size_t)(m0 - MLAT); }
        const int col0 = colt + wc * 32 + 8 * fq;
#pragma unroll
        for (int ai = 0; ai < 2; ++ai)
#pragma unroll
            for (int m = 0; m < 4; ++m) { bf16_t* rowp = base + (rowbase + (size_t)(wr * 64 + fr + ai * HALF + m * 16)) * ldc + col0;
#pragma unroll
                for (int bj = 0; bj < 2; ++bj) *(u32x4*)(rowp + bj * HALF) = pack8(acc[ai][bj][m][0], acc[ai][bj][m][1]); }
    }
};
template <bool ADD> struct EpiMerge {
    static constexpr bool PERM = true, AFTER_DRAIN = false;
    const bf16_t *Glat, *Gctx; bf16_t* Mg; int goff;
    static __device__ __forceinline__ f32x2 gate2(unsigned gw, f32x2 a) {
        f32x2 t = (f32x2){bflo(gw), bfhi(gw)} * (-1.4426950408889634f);
        t.x = __builtin_amdgcn_exp2f(t.x); t.y = __builtin_amdgcn_exp2f(t.y);
        t = t + 1.0f;
        t.x = __builtin_amdgcn_rcpf(t.x); t.y = __builtin_amdgcn_rcpf(t.y);
        return a * t;
    }
    __device__ __forceinline__ void operator()(const f32x4 (&acc)[2][2][4][2], const Unit& u, int wr, int wc, int fr, int fq) const {
        const int col0 = u.pn * BM + wc * 32 + 8 * fq;
#pragma unroll
        for (int ai = 0; ai < 2; ++ai)
#pragma unroll
            for (int m = 0; m < 4; ++m) { const size_t row = (size_t)(u.pm * BM + wr * 64 + fr + ai * HALF + m * 16);
                const bf16_t* grow = (u.pm * BM < MLAT) ? Glat + row * GATEW : Gctx + (row - MLAT) * GATEW;
#pragma unroll
                for (int bj = 0; bj < 2; ++bj) {
                    const u32x4 g = *(const u32x4*)(grow + goff + col0 + bj * HALF);
                    const f32x4 a0 = acc[ai][bj][m][0], a1 = acc[ai][bj][m][1];
                    f32x2 r0 = gate2(g.x, (f32x2){a0[0], a0[1]}), r1 = gate2(g.y, (f32x2){a0[2], a0[3]}), r2 = gate2(g.z, (f32x2){a1[0], a1[1]}), r3 = gate2(g.w, (f32x2){a1[2], a1[3]});
                    bf16_t* dst = Mg + row * DM + col0 + bj * HALF;
                    if (ADD) { const u32x4 o = *(const u32x4*)dst;
                        r0 = r0 + (f32x2){bflo(o.x), bfhi(o.x)}; r1 = r1 + (f32x2){bflo(o.y), bfhi(o.y)}; r2 = r2 + (f32x2){bflo(o.z), bfhi(o.z)}; r3 = r3 + (f32x2){bflo(o.w), bfhi(o.w)}; }
                    u32x4 w; w.x = cvt_pk_bf16(r0.x, r0.y); w.y = cvt_pk_bf16(r1.x, r1.y); w.z = cvt_pk_bf16(r2.x, r2.y); w.w = cvt_pk_bf16(r3.x, r3.y);
                    *(u32x4*)dst = w; } }
    }
};
template <bool INF32> struct EpiResid {
    static constexpr bool PERM = false, AFTER_DRAIN = false;
    const float *in_lat, *in_ctx; bf16_t* XS; const float* gate;
    __device__ __forceinline__ void operator()(const f32x4 (&acc)[2][2][4][2], const Unit& u, int wr, int wc, int fr, int fq) const {
        const int m0 = u.pm * BM; const bool lat = m0 < MLAT; const int bidx = lat ? (m0 >> 13) : 8;
        const float* xin = lat ? in_lat + (size_t)m0 * DM : in_ctx + (size_t)(m0 - MLAT) * DM; bf16_t* xs = XS + (size_t)m0 * DM;
        const int col0 = u.pn * BM + wc * 32 + 4 * fq; const float* gp = gate + (size_t)bidx * NMODV + col0;
        f32x4 gv[2][2];
#pragma unroll
        for (int bj = 0; bj < 2; ++bj)
#pragma unroll
            for (int n = 0; n < 2; ++n) gv[bj][n] = *(const f32x4*)(gp + bj * HALF + n * 16);
#pragma unroll
        for (int ai = 0; ai < 2; ++ai)
#pragma unroll
            for (int m = 0; m < 4; ++m) { const size_t off = (size_t)(wr * 64 + fr + ai * HALF + m * 16) * DM + col0;
#pragma unroll
                for (int bj = 0; bj < 2; ++bj)
#pragma unroll
                    for (int n = 0; n < 2; ++n) { f32x4 xi;
                        if (INF32) xi = *(const f32x4*)(xin + off + bj * HALF + n * 16);
                        else { const u32x2 w = *(const u32x2*)(xs + off + bj * HALF + n * 16); xi = (f32x4){bflo(w.x), bfhi(w.x), bflo(w.y), bfhi(w.y)}; }
                        const f32x4 xo = xi + gv[bj][n] * acc[ai][bj][m][n]; u32x2 o; o.x = cvt_pk_bf16(xo[0], xo[1]); o.y = cvt_pk_bf16(xo[2], xo[3]);
                        *(u32x2*)(xs + off + bj * HALF + n * 16) = o; } }
    }
};
struct EpiSwiglu {
    static constexpr bool PERM = true, AFTER_DRAIN = false;
    bf16_t* A;
    __device__ __forceinline__ void operator()(const f32x4 (&acc)[2][2][4][2], const Unit& u, int wr, int wc, int fr, int fq) const {
        const int col0 = u.pn * HALF + wc * 32 + 8 * fq;
#pragma unroll
        for (int ai = 0; ai < 2; ++ai)
#pragma unroll
            for (int m = 0; m < 4; ++m) { const size_t row = (size_t)(u.pm * BM + wr * 64 + fr + ai * HALF + m * 16);
                f32x4 r[2];
#pragma unroll
                for (int n = 0; n < 2; ++n) { const f32x4 g = acc[ai][0][m][n], up = acc[ai][1][m][n];
#pragma unroll
                    for (int e = 0; e < 4; ++e) r[n][e] = g[e] * sigmoidf_(g[e]) * up[e]; }
                *(u32x4*)(A + row * DFF + col0) = pack8(r[0], r[1]); }
    }
};
}
namespace attn {
using bf16 = __hip_bfloat16;
constexpr int D = 128, NW = 8, QBLK = 32, KVBLK = 64;
constexpr float SCALE = 0.088388347648318440f;
constexpr float THR = 8.f;
constexpr int SDEPTH = 2;
constexpr int LDQ = 1024, LDK = 256, LDO = 1024;
constexpr size_t SHM_V = KVBLK * D * 2, SHM_K = KVBLK * D * 2, SHM_ATTN = 2 * SHM_V + 2 * SHM_K + NW * 64 * 4;

using bf16x8 = __attribute__((ext_vector_type(8))) short;
using s16x4  = __attribute__((ext_vector_type(4))) short;
using f32x16 = __attribute__((ext_vector_type(16))) float;
using f32x8  = __attribute__((ext_vector_type(8))) float;
using u32x4  = __attribute__((ext_vector_type(4))) unsigned;
using f32x2  = __attribute__((ext_vector_type(2))) float;
using f32x4  = __attribute__((ext_vector_type(4))) float;
#define KSWZ(row, colB) ((row) * 256 + ((colB) ^ (((row) & 7) << 4)))
#define SBAR() __builtin_amdgcn_sched_barrier(0)
__device__ __forceinline__ int crow(int r, int hi) { return (r & 3) + 8 * (r >> 2) + 4 * hi; }
__device__ __forceinline__ unsigned cvtpk(float lo, float hi) {
  unsigned r; asm volatile("v_cvt_pk_bf16_f32 %0, %1, %2" : "=v"(r) : "v"(lo), "v"(hi)); return r;
}
template <typename TIn> struct Stage;
template <> struct Stage<bf16>  { using T = bf16x8;
  __device__ static __forceinline__ T ld8(const bf16* p) { return *reinterpret_cast<const bf16x8*>(p); }
  __device__ static __forceinline__ bf16x8 tobf(T x) { return x; } };
__device__ __forceinline__ void partialSM(f32x16& p0, f32x16& p1, float& m_reg, float& mn, float& alpha) {
  constexpr float C = SCALE * 1.4426950408889634f;
  float pmax = p0[0]; for (int r = 1; r < 16; ++r) pmax = fmaxf(pmax, p0[r]); for (int r = 0; r < 16; ++r) pmax = fmaxf(pmax, p1[r]);
  { auto rr = __builtin_amdgcn_permlane32_swap(__float_as_uint(pmax), __float_as_uint(pmax), false, false);
    pmax = fmaxf(__uint_as_float(rr[0]), __uint_as_float(rr[1])); }
  if (__builtin_expect(__all(pmax - m_reg <= THR / SCALE), 1)) { mn = m_reg; alpha = 1.f; }
  else { mn = fmaxf(m_reg, pmax); alpha = __builtin_amdgcn_exp2f((m_reg - mn) * C); m_reg = mn; }
  float mnC = -mn * C;
  for (int r = 0; r < 16; ++r) p0[r] = fmaf(p0[r], C, mnC); for (int r = 0; r < 16; ++r) p1[r] = fmaf(p1[r], C, mnC);
  for (int r = 0; r < 16; ++r) p0[r] = __builtin_amdgcn_exp2f(p0[r]);
}
__device__ __forceinline__ void finishSM(f32x16& p0, f32x16& p1, float alpha, float& l_reg, bf16x8& pa0, bf16x8& pa1, bf16x8& pa2, bf16x8& pa3) {
  for (int r = 0; r < 16; ++r) p1[r] = __builtin_amdgcn_exp2f(p1[r]);
  float ps = 0; for (int r = 0; r < 16; ++r) ps += p0[r]; for (int r = 0; r < 16; ++r) ps += p1[r];
  { auto rr = __builtin_amdgcn_permlane32_swap(__float_as_uint(ps), __float_as_uint(ps), false, false);
    ps = __uint_as_float(rr[0]) + __uint_as_float(rr[1]); }
  l_reg = l_reg * alpha + ps;
#define PK4(P, BASE, OUT) do { unsigned a0 = cvtpk(P[BASE + 0], P[BASE + 1]), a1 = cvtpk(P[BASE + 2], P[BASE + 3]);   \
    unsigned b0 = cvtpk(P[BASE + 4], P[BASE + 5]), b1 = cvtpk(P[BASE + 6], P[BASE + 7]);                              \
    auto r0 = __builtin_amdgcn_permlane32_swap(a0, b0, false, false); auto r1 = __builtin_amdgcn_permlane32_swap(a1, b1, false, false); \
    u32x4 w = {r0[0], r1[0], r0[1], r1[1]}; OUT = *reinterpret_cast<bf16x8*>(&w); } while (0)
  PK4(p0, 0, pa0); PK4(p0, 8, pa1); PK4(p1, 0, pa2); PK4(p1, 8, pa3);
#undef PK4
}
__device__ __forceinline__ void qkt(f32x16& p0, f32x16& p1, const bf16* Ks, const bf16x8* qr, int r32, int hi) {
  p0 = f32x16{}; p1 = f32x16{};
  for (int d0 = 0; d0 < 8; ++d0) { int cb = (d0 * 16 + hi * 8) * 2;
    bf16x8 b0 = *reinterpret_cast<const bf16x8*>((const char*)Ks + KSWZ(r32, cb));
    bf16x8 b1 = *reinterpret_cast<const bf16x8*>((const char*)Ks + KSWZ(32 + r32, cb));
    p0 = __builtin_amdgcn_mfma_f32_32x32x16_bf16(b0, qr[d0], p0, 0, 0, 0);
    p1 = __builtin_amdgcn_mfma_f32_32x32x16_bf16(b1, qr[d0], p1, 0, 0, 0); }
}
__device__ __forceinline__ int v_st(int k, int c) { const int kk = (k & ~0xC) | ((k & 4) << 1) | ((k & 8) >> 1); return ((kk >> 3) * 4 + (c >> 5)) * 512 + ((kk & 7) * 32 + (c & 31)) * 2; }
__device__ __forceinline__ int v_rd_base(int lane) { return ((lane & 3) << 3) | (((lane >> 2) & 3) << 6) | (((lane >> 4) & 1) << 5) | (((lane >> 5) & 1) << 8); }
constexpr int v_rd_off(int d0, int ks, int half) { return d0 * 512 + ks * 4096 + half * 2048; }
template <int OFF> __device__ __forceinline__ s16x4 tr_read(int vb) {
  s16x4 r; asm volatile("ds_read_b64_tr_b16 %0, %1 offset:%2" : "=&v"(r) : "v"(vb), "i"(OFF) : "memory"); return r;
}
template <int D0> __device__ __forceinline__ void pv_one(f32x16& od, int vb, bf16x8 pa0, bf16x8 pa1, bf16x8 pa2, bf16x8 pa3) {
  const s16x4 l0 = tr_read<v_rd_off(D0, 0, 0)>(vb), h0 = tr_read<v_rd_off(D0, 0, 1)>(vb), l1 = tr_read<v_rd_off(D0, 1, 0)>(vb), h1 = tr_read<v_rd_off(D0, 1, 1)>(vb);
  const s16x4 l2 = tr_read<v_rd_off(D0, 2, 0)>(vb), h2 = tr_read<v_rd_off(D0, 2, 1)>(vb), l3 = tr_read<v_rd_off(D0, 3, 0)>(vb), h3 = tr_read<v_rd_off(D0, 3, 1)>(vb);
  asm volatile("s_waitcnt lgkmcnt(0)" ::: "memory"); SBAR();
#define PK(L, H) (bf16x8){L[0], L[1], L[2], L[3], H[0], H[1], H[2], H[3]}
  od = __builtin_amdgcn_mfma_f32_32x32x16_bf16(pa0, PK(l0, h0), od, 0, 0, 0);
  od = __builtin_amdgcn_mfma_f32_32x32x16_bf16(pa1, PK(l1, h1), od, 0, 0, 0);
  od = __builtin_amdgcn_mfma_f32_32x32x16_bf16(pa2, PK(l2, h2), od, 0, 0, 0);
  od = __builtin_amdgcn_mfma_f32_32x32x16_bf16(pa3, PK(l3, h3), od, 0, 0, 0);
#undef PK
}
__device__ __forceinline__ void pv_d0(f32x16* o, int vb, bf16x8 pa0, bf16x8 pa1, bf16x8 pa2, bf16x8 pa3) {
  pv_one<0>(o[0], vb, pa0, pa1, pa2, pa3); pv_one<1>(o[1], vb, pa0, pa1, pa2, pa3); pv_one<2>(o[2], vb, pa0, pa1, pa2, pa3); pv_one<3>(o[3], vb, pa0, pa1, pa2, pa3);
}

template <typename TQ>
__device__ __forceinline__ void attn_dense_body(const TQ* Qb, const bf16* __restrict__ Kh, const bf16* __restrict__ Vh,
                                                bf16* Ob, int seq, char* lds, const int tid_in, const float* qgain, const f32x2* rope_rows) {
  using St = Stage<bf16>; using SQ = Stage<TQ>;
  const int tid = tid_in, wid = tid >> 6, lane = tid & 63, r32 = lane & 31, hi = lane >> 5;
  bf16* V_lds = (bf16*)lds; bf16* K_lds = (bf16*)(lds + 2 * SHM_V);
  float* ws = (float*)(lds + 2 * SHM_V + 2 * SHM_K) + wid * 64; float* li_l = ws; float* al_l = ws + 32;
  float m_reg = -1e30f, l_reg = 0; f32x16 o[4] = {}; bf16x8 qr[8];
  const TQ* Qw = Qb + (long)(wid * QBLK + r32) * LDQ + hi * 8;
#pragma unroll
  for (int d0 = 0; d0 < 8; ++d0) qr[d0] = SQ::tobf(SQ::ld8(Qw + d0 * 16));
  {
    float ss = 0.f;
#pragma unroll
    for (int d0 = 0; d0 < 8; ++d0) { const u32x4 w = __builtin_bit_cast(u32x4, qr[d0]);
#pragma unroll
      for (int p = 0; p < 4; ++p) { const float x0 = __uint_as_float(w[p] << 16), x1 = __uint_as_float(w[p] & 0xffff0000u); ss += x0 * x0 + x1 * x1; } }
    { auto rr = __builtin_amdgcn_permlane32_swap(__float_as_uint(ss), __float_as_uint(ss), false, false); ss = __uint_as_float(rr[0]) + __uint_as_float(rr[1]); }
    const float rstd = __builtin_amdgcn_rsqf(ss * (1.f / 128.f) + 1e-6f);
    const float* gq = qgain + hi * 8; const f32x2* rp = rope_rows ? rope_rows + (long)(wid * QBLK + r32) * 64 + hi * 4 : nullptr;
#pragma unroll
    for (int d0 = 0; d0 < 8; ++d0) { u32x4 w = __builtin_bit_cast(u32x4, qr[d0]);
      const f32x4 ga = *(const f32x4*)(gq + d0 * 16), gb = *(const f32x4*)(gq + d0 * 16 + 4);
#pragma unroll
      for (int p = 0; p < 4; ++p) { float x0 = __uint_as_float(w[p] << 16) * rstd * (p < 2 ? ga[(2 * p) & 3] : gb[(2 * p) & 3]), x1 = __uint_as_float(w[p] & 0xffff0000u) * rstd * (p < 2 ? ga[(2 * p + 1) & 3] : gb[(2 * p + 1) & 3]);
        if (rp) { const f32x2 cs = rp[d0 * 8 + p]; const float y0 = x0 * cs.x - x1 * cs.y, y1 = x0 * cs.y + x1 * cs.x; x0 = y0; x1 = y1; }
        w[p] = cvtpk(x0, x1); }
      qr[d0] = __builtin_bit_cast(bf16x8, w); } }
  const int sr = tid >> 4, sc = (tid & 15) * 8, vst0 = v_st(sr, sc), vst1 = v_st(32 + sr, sc);
  const int vb0 = (int)(uintptr_t)V_lds + v_rd_base(lane);
  struct { typename St::T vs0, vs1, ks0, ks1; } sr_[SDEPTH];
#define SLOAD(i, k0) do { sr_[i].vs0 = St::ld8(&Vh[(long)((k0) + sr) * LDK + sc]); sr_[i].vs1 = St::ld8(&Vh[(long)((k0) + 32 + sr) * LDK + sc]); \
    sr_[i].ks0 = St::ld8(&Kh[(long)((k0) + sr) * LDK + sc]); sr_[i].ks1 = St::ld8(&Kh[(long)((k0) + 32 + sr) * LDK + sc]); } while (0)
#define SWRITE(b, i) do { *(bf16x8*)((char*)V_lds + (b) * SHM_V + vst0) = St::tobf(sr_[i].vs0);          \
    *(bf16x8*)((char*)V_lds + (b) * SHM_V + vst1) = St::tobf(sr_[i].vs1); int kc = sc * 2;               \
    *(bf16x8*)((char*)K_lds + (b) * SHM_K + KSWZ(sr, kc)) = St::tobf(sr_[i].ks0);                       \
    *(bf16x8*)((char*)K_lds + (b) * SHM_K + KSWZ(32 + sr, kc)) = St::tobf(sr_[i].ks1); } while (0)
#define SWAIT() do { if constexpr (SDEPTH == 2) asm volatile("s_waitcnt vmcnt(4)" ::: "memory"); else asm volatile("s_waitcnt vmcnt(0)" ::: "memory"); } while (0)
#define RESC(a) do { if (__any((a) < 1.f)) { if (hi == 0) al_l[r32] = (a); asm volatile("s_waitcnt lgkmcnt(0)" ::: "memory"); \
    for (int d = 0; d < 4; ++d) for (int r = 0; r < 16; ++r) o[d][r] *= al_l[crow(r, hi)]; } } while (0)
  f32x16 pA0, pA1, pB0, pB1; float mnA, mnB, alA, alB; bf16x8 pa0, pa1, pa2, pa3; const int NT = seq / KVBLK;
  constexpr int SE = 0, SO = SDEPTH - 1;
  SLOAD(SE, 0); asm volatile("s_waitcnt vmcnt(0)" ::: "memory"); SWRITE(0, SE); __syncthreads();
  qkt(pA0, pA1, K_lds, qr, r32, hi); partialSM(pA0, pA1, m_reg, mnA, alA);
  SLOAD(SO, KVBLK); if constexpr (SDEPTH == 2) { if (2 < NT) SLOAD(SE, 2 * KVBLK); }
  SWAIT(); SWRITE(1, SO); __syncthreads();
  for (int j = 1; j + 1 < NT; j += 2) {
    SBAR(); qkt(pB0, pB1, (bf16*)((char*)K_lds + SHM_K), qr, r32, hi);
    finishSM(pA0, pA1, alA, l_reg, pa0, pa1, pa2, pa3); SBAR();
    SLOAD(SO, (j + SDEPTH) * KVBLK); SBAR();
    pv_d0(o, vb0, pa0, pa1, pa2, pa3); partialSM(pB0, pB1, m_reg, mnB, alB);
    __syncthreads(); SWAIT(); SWRITE(0, SE);
    RESC(alB); __syncthreads();
    SBAR(); qkt(pA0, pA1, K_lds, qr, r32, hi);
    finishSM(pB0, pB1, alB, l_reg, pa0, pa1, pa2, pa3); SBAR();
    if (SDEPTH == 1 || j + 3 < NT) SLOAD(SE, (j + 1 + SDEPTH) * KVBLK); SBAR();
    pv_d0(o, vb0 + (int)SHM_V, pa0, pa1, pa2, pa3); partialSM(pA0, pA1, m_reg, mnA, alA);
    __syncthreads(); SWAIT(); SWRITE(1, SO);
    RESC(alA); __syncthreads();
  }
  SBAR(); qkt(pB0, pB1, (bf16*)((char*)K_lds + SHM_K), qr, r32, hi);
  finishSM(pA0, pA1, alA, l_reg, pa0, pa1, pa2, pa3); SBAR();
  pv_d0(o, vb0, pa0, pa1, pa2, pa3); partialSM(pB0, pB1, m_reg, mnB, alB);
  __syncthreads(); RESC(alB);
  finishSM(pB0, pB1, alB, l_reg, pa0, pa1, pa2, pa3); SBAR();
  pv_d0(o, vb0 + (int)SHM_V, pa0, pa1, pa2, pa3);
  if (hi == 0) li_l[r32] = l_reg; asm volatile("s_waitcnt lgkmcnt(0)" ::: "memory");
  float rli[16];
#pragma unroll
  for (int r = 0; r < 16; ++r) rli[r] = __builtin_amdgcn_rcpf(li_l[crow(r, hi)]);
  unsigned short* Ow = (unsigned short*)Ob + (long)(wid * QBLK) * LDO;
#pragma unroll
  for (int r = 0; r < 16; ++r) { int orow = crow(r, hi);
    for (int d0 = 0; d0 < 4; ++d0) Ow[(long)orow * LDO + d0 * 32 + r32] = (unsigned short)(cvtpk(o[d0][r] * rli[r], 0.f) & 0xffffu); }
#undef SLOAD
#undef SWRITE
#undef SWAIT
#undef RESC
}

}
#define XB_TMO      128
#define XB_XCNT(j)  (256  + 64 * (j))
#define XB_XSUB(j)  (1280 + 64 * (j))
#define XB_XGEN(j)  (2304 + 64 * (j))
#define XB_TOP      3328
#define XB_TOPGEN   3392
#define XCD_BAR_WORDS 3456
#define XB_SPIN_CAP (1u << 18)

__device__ __forceinline__ unsigned xb_ld(unsigned* p)              { return __hip_atomic_load(p, __ATOMIC_RELAXED, __HIP_MEMORY_SCOPE_AGENT); }
__device__ __forceinline__ unsigned xb_add(unsigned* p, unsigned v) { return __hip_atomic_fetch_add(p, v, __ATOMIC_RELAXED, __HIP_MEMORY_SCOPE_AGENT); }
__device__ __forceinline__ unsigned xb_xcc_id() { return (unsigned)__builtin_amdgcn_s_getreg((3 << 11) | 20) & 0xFu; }
#define XB_SPIN(cond, bar) do { unsigned _sp = 0; while (cond) { __builtin_amdgcn_s_sleep(1); \
    if ((++_sp & 255u) == 0u) { if (xb_ld(&(bar)[XB_TMO])) break; if (_sp > XB_SPIN_CAP) { atomicAdd(&(bar)[XB_TMO], 1u); break; } } } } while (0)

struct XcdBarrier {
    int tid; unsigned* bar; unsigned x;
    volatile LAS unsigned* st;
};

__device__ __forceinline__ XcdBarrier xcd_barrier_post(unsigned* bar, volatile LAS unsigned* st, int tid) {
    XcdBarrier b; b.tid = tid; b.bar = bar; b.x = xb_xcc_id(); b.st = st;
    if (b.tid == 0) (void)xb_add(&bar[XB_XCNT(b.x)], 1u);
    return b;
}
__device__ __forceinline__ void xcd_barrier_complete(unsigned* bar, unsigned x, unsigned& nloc, unsigned& nx) {
    const unsigned G = gridDim.x * gridDim.y * gridDim.z;
    unsigned sum, cnt, mine, sp = 0u;
    for (;;) {
        sum = 0u; cnt = 0u; mine = 0u;
#pragma unroll
        for (unsigned j = 0; j < 16; ++j) { const unsigned c = xb_ld(&bar[XB_XCNT(j)]); sum += c; cnt += (c > 0u) ? 1u : 0u; mine = (j == x) ? c : mine; }
        if (sum == G) break;
        __builtin_amdgcn_s_sleep(1);
        if ((++sp & 255u) == 0u) { if (xb_ld(&bar[XB_TMO])) break; if (sp > XB_SPIN_CAP) { atomicAdd(&bar[XB_TMO], 1u); break; } }
    }
    nloc = mine > 0u ? mine : 1u; nx = cnt > 0u ? cnt : 1u;
}

__device__ __forceinline__ void xcd_barrier(const XcdBarrier& b) {
    asm volatile("s_waitcnt vmcnt(0)" ::: "memory");
    __syncthreads();
    if (b.tid == 0) {
        unsigned* bar = b.bar;
        __builtin_amdgcn_s_waitcnt(0);
        unsigned nloc = b.st[0], nx = b.st[1];
        const unsigned old = xb_add(&bar[XB_XSUB(b.x)], 1u);
        const unsigned gen = old / nloc;
        if (old + 1u == (gen + 1u) * nloc) {
            __builtin_amdgcn_fence(__ATOMIC_RELEASE, "agent");
            asm volatile("s_waitcnt vmcnt(0)" ::: "memory");
            const unsigned og = xb_add(&bar[XB_TOP], 1u);
            const unsigned tg = og / nx;
            if (og + 1u == (tg + 1u) * nx) xb_add(&bar[XB_TOPGEN], 1u);
            else XB_SPIN(xb_ld(&bar[XB_TOPGEN]) == tg, bar);
            __builtin_amdgcn_fence(__ATOMIC_ACQUIRE, "agent");
            xb_add(&bar[XB_XGEN(b.x)], 1u);
            asm volatile("s_waitcnt vmcnt(0)" ::: "memory");
        } else {
            XB_SPIN(xb_ld(&bar[XB_XGEN(b.x)]) == gen, bar);
            __builtin_amdgcn_fence(__ATOMIC_ACQUIRE, "agent");
            asm volatile("s_waitcnt vmcnt(0)" ::: "memory");
        }
    }
    __syncthreads();
}

#define LDS_WAIT() asm volatile("s_waitcnt lgkmcnt(0)" ::: "memory")
__device__ __forceinline__ void transpose_item(const float* W, int K, int N, bf16_t* WT, int k0, int n0, int drow0, LAS float* scr, int lane) {
#pragma unroll
    for (int i = 0; i < 32; ++i) { const int kk = 2 * i + (lane >> 5); scr[kk * 33 + (lane & 31)] = W[(size_t)(k0 + kk) * N + n0 + (lane & 31)]; }
    LDS_WAIT(); asm volatile("" ::: "memory");
    const int c = lane & 7;
#pragma unroll
    for (int j = 0; j < 4; ++j) { const int n = (lane >> 3) + 8 * j; const LAS float* s = scr + (8 * c) * 33 + n;
        u32x4 o; o.x = pk2(s[0 * 33], s[1 * 33]); o.y = pk2(s[2 * 33], s[3 * 33]); o.z = pk2(s[4 * 33], s[5 * 33]); o.w = pk2(s[6 * 33], s[7 * 33]);
        *(u32x4*)(WT + (size_t)(drow0 + n) * K + k0 + 8 * c) = o; }
    LDS_WAIT(); asm volatile("" ::: "memory");
}
__device__ __forceinline__ void phase_weights(const Params& p, LAS unsigned char* lds, int gw, int NGW, int wave, int lane) {
    LAS float* scr = (LAS float*)(lds + wave * 16384);
    constexpr int I0 = 16 * 160, I1 = 16 * 32, I2 = 8 * 32, I3 = 16 * 32, I4 = 16 * 176, I5 = 44 * 32, IL = I0 + I1 + I2 + I3 + I4 + I5;
    for (int it = gw; it < 2 * IL; it += NGW) {
        const int l = it / IL; int r = it % IL; unsigned char* wb = p.ws + WS_W + (size_t)l * WL_STRIDE;
        if (r < I0) { const int kb = r / 160, nb = r % 160; transpose_item(p.w_in + (size_t)l * DM * PROJ, DM, PROJ, (bf16_t*)(wb + WL_IN), kb * 64, nb * 32, nb * 32, scr, lane); continue; } r -= I0;
        if (r < I1) { const int kb = r / 32, nb = r % 32; transpose_item(p.w_oa + (size_t)l * DM * DM, DM, DM, (bf16_t*)(wb + WL_OA), kb * 64, nb * 32, nb * 32, scr, lane); continue; } r -= I1;
        if (r < I2) { const int kb = r / 32, nb = r % 32; transpose_item(p.w_oh + (size_t)l * HYW * DM, HYW, DM, (bf16_t*)(wb + WL_OH), kb * 64, nb * 32, nb * 32, scr, lane); continue; } r -= I2;
        if (r < I3) { const int kb = r / 32, nb = r % 32; transpose_item(p.w_out + (size_t)l * DM * DM, DM, DM, (bf16_t*)(wb + WL_OUT), kb * 64, nb * 32, nb * 32, scr, lane); continue; } r -= I3;
        if (r < I4) { const int kb = r / 176, nb = r % 176; const int n0 = nb * 32; const int nn = n0 < DFF ? n0 : n0 - DFF; const int drow = 256 * (nn / 128) + (nn % 128) + (n0 < DFF ? 0 : 128);
            transpose_item(p.w_gu + (size_t)l * DM * 2 * DFF, DM, 2 * DFF, (bf16_t*)(wb + WL_GU), kb * 64, n0, drow, scr, lane); continue; } r -= I4;
        { const int kb = r / 32, nb = r % 32; transpose_item(p.w_dn + (size_t)l * DFF * DM, DFF, DM, (bf16_t*)(wb + WL_DN), kb * 64, nb * 32, nb * 32, scr, lane); }
    }
}
__device__ __forceinline__ void mod_unit(const Params& p, int unit, LAS unsigned char* lds, int tid) {
    LAS float* s = (LAS float*)lds; LAS float* red = (LAS float*)(lds + 40960);
    const int l = unit / 96, n0 = (unit % 96) * 64, col = tid & 63, ks = tid >> 6;
    for (int e = tid; e < 9 * 1024; e += 512) { const float v = e < 8192 ? p.c[e] : p.c_ctx[e - 8192]; s[e] = v / (1.f + __expf(-v)); }
    __syncthreads();
    const float* W = p.w_mod + (size_t)l * DM * NMODV + n0 + col;
    float acc[9];
#pragma unroll
    for (int j = 0; j < 9; ++j) acc[j] = 0.f;
#pragma unroll 2
    for (int k = ks * 128; k < ks * 128 + 128; k += 4) {
        const float w0 = W[(size_t)k * NMODV], w1 = W[(size_t)(k + 1) * NMODV], w2 = W[(size_t)(k + 2) * NMODV], w3 = W[(size_t)(k + 3) * NMODV];
#pragma unroll
        for (int j = 0; j < 9; ++j) { const f32x4 sv = *(const LAS f32x4*)(s + j * 1024 + k); acc[j] += sv[0] * w0 + sv[1] * w1 + sv[2] * w2 + sv[3] * w3; }
    }
#pragma unroll
    for (int j = 0; j < 9; ++j) red[(ks * 9 + j) * 64 + col] = acc[j];
    __syncthreads();
    for (int e = tid; e < 9 * 64; e += 512) { const int j = e >> 6, c = e & 63; float sum = 0.f;
#pragma unroll
        for (int q = 0; q < 8; ++q) sum += red[(q * 9 + j) * 64 + c];
        ((float*)(p.ws + WS_MOD))[((size_t)l * 9 + j) * NMODV + n0 + c] = sum + p.b_mod[(size_t)l * NMODV + n0 + c]; }
    __syncthreads();
}
__device__ __forceinline__ void shiftw_unit(const float* sbase, const float* W, int ldw, int n0, float* out, int ldo, LAS unsigned char* lds, int tid) {
    LAS float* s = (LAS float*)lds; LAS float* red = (LAS float*)(lds + 40960);
    const int col = tid & 63, ks = tid >> 6;
    for (int e = tid; e < 9 * 1024; e += 512) s[e] = sbase[(size_t)(e >> 10) * NMODV + (e & 1023)];
    __syncthreads();
    const float* Wc = W + n0 + col;
    float acc[9];
#pragma unroll
    for (int j = 0; j < 9; ++j) acc[j] = 0.f;
#pragma unroll 2
    for (int k = ks * 128; k < ks * 128 + 128; k += 4) {
        const float w0 = Wc[(size_t)k * ldw], w1 = Wc[(size_t)(k + 1) * ldw], w2 = Wc[(size_t)(k + 2) * ldw], w3 = Wc[(size_t)(k + 3) * ldw];
#pragma unroll
        for (int j = 0; j < 9; ++j) { const f32x4 sv = *(const LAS f32x4*)(s + j * 1024 + k); acc[j] += sv[0] * w0 + sv[1] * w1 + sv[2] * w2 + sv[3] * w3; }
    }
#pragma unroll
    for (int j = 0; j < 9; ++j) red[(ks * 9 + j) * 64 + col] = acc[j];
    __syncthreads();
    for (int e = tid; e < 9 * 64; e += 512) { const int j = e >> 6, c = e & 63; float sum = 0.f;
#pragma unroll
        for (int qq = 0; qq < 8; ++qq) sum += red[(qq * 9 + j) * 64 + c];
        out[(size_t)j * ldo + n0 + c] = sum; }
    __syncthreads();
}
constexpr int FW_OFF = 32768 / 4, FW2_O = 2112, FW3_O = 6208, FB1_O = 10304, FB2_O = 10368, FB3_O = 10432, FRQ_O = 10496;
__device__ __forceinline__ void filter_stage_weights(const Params& p, int l, LAS unsigned char* lds, int tid) {
    LAS float* W = (LAS float*)lds + FW_OFF;
    for (int e = tid; e < 2112; e += 512) W[e] = p.fw1[(size_t)l * 2112 + e];
    for (int e = tid; e < 4096; e += 512) { W[FW2_O + e] = p.fw2[(size_t)l * 4096 + e]; W[FW3_O + e] = p.fw3[(size_t)l * 4096 + e]; }
    if (tid < 64) { W[FB1_O + tid] = p.fb1[l * 64 + tid]; W[FB2_O + tid] = p.fb2[l * 64 + tid]; W[FB3_O + tid] = p.fb3[l * 64 + tid]; }
    if (tid < 192) W[FRQ_O + tid] = p.freq[(size_t)l * 192 + tid];
    __syncthreads();
}
__device__ __forceinline__ void filter_unit(const Params& p, int l, int L, int t0, float* dst, bool transposed, LAS unsigned char* lds, int tid) {
    LAS float* z = (LAS float*)lds; LAS float* h1 = z + 1024; LAS float* h2 = h1 + 1024; LAS float* h3t = h2 + 1024;
    const LAS float* W = (const LAS float*)lds + FW_OFF;
    const float wstep = (float)(2.0 * 3.14159265358979323846 / (double)L), invL1 = 1.f / (float)(L - 1);
    for (int e = tid; e < 16 * 33; e += 512) { const int tl = e / 33, i = e % 33; const float tf = (float)(t0 + tl); float val;
        if (i == 0) val = tf * invL1;
        else { const int j = (i - 1) & 15; const float f = 1e-4f + (float)j * ((15.f - 1e-4f) / 15.f); const float a = f * (wstep * tf); val = (i <= 16) ? cosf(a) : -sinf(a); }
        z[tl * 36 + i] = val; }
    __syncthreads();
    for (int e = tid; e < 1024; e += 512) { const int tl = e >> 6, m = e & 63; float sacc = W[FB1_O + m];
#pragma unroll 3
        for (int i = 0; i < 33; ++i) sacc += z[tl * 36 + i] * W[i * 64 + m];
        h1[e] = sinf(W[FRQ_O + m] * sacc); }
    __syncthreads();
    for (int e = tid; e < 1024; e += 512) { const int tl = e >> 6, m = e & 63; float sacc = W[FB2_O + m];
#pragma unroll 4
        for (int i = 0; i < 64; ++i) sacc += h1[tl * 64 + i] * W[FW2_O + i * 64 + m];
        h2[e] = sinf(W[FRQ_O + 64 + m] * sacc); }
    __syncthreads();
    for (int e = tid; e < 1024; e += 512) { const int tl = e >> 6, m = e & 63; float sacc = W[FB3_O + m];
#pragma unroll 4
        for (int i = 0; i < 64; ++i) sacc += h2[tl * 64 + i] * W[FW3_O + i * 64 + m];
        h3t[m * 16 + tl] = sinf(W[FRQ_O + 128 + m] * sacc); }
    __syncthreads();
    const float mind = -3.0701134573253945f, maxd = -15.350567286626972f;
    { const float* w4 = p.fw4 + (size_t)l * 64 * 1024 + tid; float acc0[16], acc1[16];
#pragma unroll
      for (int tl = 0; tl < 16; ++tl) { acc0[tl] = 0.f; acc1[tl] = 0.f; }
#pragma unroll 4
      for (int m = 0; m < 64; ++m) { const float wa = w4[(size_t)m * 1024], wb = w4[(size_t)m * 1024 + 512];
          const f32x4 h0 = *(const LAS f32x4*)(h3t + m * 16), hq1 = *(const LAS f32x4*)(h3t + m * 16 + 4), hq2 = *(const LAS f32x4*)(h3t + m * 16 + 8), hq3 = *(const LAS f32x4*)(h3t + m * 16 + 12);
#pragma unroll
          for (int k = 0; k < 4; ++k) { acc0[k] += h0[k] * wa; acc1[k] += h0[k] * wb; acc0[4 + k] += hq1[k] * wa; acc1[4 + k] += hq1[k] * wb;
                                        acc0[8 + k] += hq2[k] * wa; acc1[8 + k] += hq2[k] * wb; acc0[12 + k] += hq3[k] * wa; acc1[12 + k] += hq3[k] * wb; } }
      const float delta = fabsf(mind + (float)tid * ((maxd - mind) / 511.f));
#pragma unroll
      for (int tl = 0; tl < 16; ++tl) { const float dc = expf(-((float)(t0 + tl) * invL1) * delta); acc0[tl] *= dc; acc1[tl] *= dc; }
      if (transposed) { float* d0 = dst + (size_t)tid * SEQ + t0; float* d1 = dst + (size_t)(tid + 512) * SEQ + t0;
#pragma unroll
          for (int q = 0; q < 4; ++q) { *(f32x4*)(d0 + 4 * q) = (f32x4){acc0[4 * q], acc0[4 * q + 1], acc0[4 * q + 2], acc0[4 * q + 3]}; *(f32x4*)(d1 + 4 * q) = (f32x4){acc1[4 * q], acc1[4 * q + 1], acc1[4 * q + 2], acc1[4 * q + 3]}; } }
      else {
#pragma unroll
          for (int tl = 0; tl < 16; ++tl) { dst[(size_t)(t0 + tl) * 1024 + tid] = acc0[tl]; dst[(size_t)(t0 + tl) * 1024 + tid + 512] = acc1[tl]; } }
    }
    __syncthreads();
}
__device__ __forceinline__ f32x2 cmul(f32x2 a, f32x2 b) { return (f32x2){a.x * b.x - a.y * b.y, a.x * b.y + a.y * b.x}; }
__device__ __forceinline__ int PADI(int i) { return i + 4 * (i >> 6); }
__device__ __forceinline__ f32x2 tw_get(const LAS f32x2* T, int k) { const f32x2 h = T[k & 2047]; const float c = 0.70710678118654752f; const f32x2 r = {(h.x + h.y) * c, (h.y - h.x) * c}; return (k & 2048) ? r : h; }
__device__ __forceinline__ void bfly_fwd(f32x2& a, f32x2& b, f32x2& c, f32x2& d, f32x2 w1) {
    const f32x2 w2 = cmul(w1, w1), w3 = cmul(w2, w1);
    const f32x2 s0 = a + c, s1 = a - c, s2 = b + d, s3 = b - d;
    a = s0 + s2; b = cmul((f32x2){s1.x + s3.y, s1.y - s3.x}, w1); c = cmul(s0 - s2, w2); d = cmul((f32x2){s1.x - s3.y, s1.y + s3.x}, w3);
}
__device__ __forceinline__ void bfly_inv(f32x2& a, f32x2& b, f32x2& c, f32x2& d, f32x2 w1c) {
    const f32x2 w2 = cmul(w1c, w1c), w3 = cmul(w2, w1c);
    b = cmul(b, w1c); c = cmul(c, w2); d = cmul(d, w3);
    const f32x2 s0 = a + c, s1 = a - c, s2 = b + d, s3 = b - d;
    a = s0 + s2; b = (f32x2){s1.x - s3.y, s1.y + s3.x}; c = s0 - s2; d = (f32x2){s1.x + s3.y, s1.y - s3.x};
}
__device__ __forceinline__ void bfly_fwd1(f32x2& a, f32x2& b, f32x2& c, f32x2& d) {
    const f32x2 s0 = a + c, s1 = a - c, s2 = b + d, s3 = b - d;
    a = s0 + s2; b = (f32x2){s1.x + s3.y, s1.y - s3.x}; c = s0 - s2; d = (f32x2){s1.x - s3.y, s1.y + s3.x};
}
__device__ __forceinline__ void bfly_inv1(f32x2& a, f32x2& b, f32x2& c, f32x2& d) {
    const f32x2 s0 = a + c, s1 = a - c, s2 = b + d, s3 = b - d;
    a = s0 + s2; b = (f32x2){s1.x - s3.y, s1.y + s3.x}; c = s0 - s2; d = (f32x2){s1.x + s3.y, s1.y - s3.x};
}
template <int PS> __device__ __forceinline__ void fwd2_regs(f32x2 (&e)[4][4], const LAS f32x2* tw, int j) {
    constexpr int q16 = (NFFT >> (2 * PS)) / 16;
#pragma unroll
    for (int k2 = 0; k2 < 4; ++k2) bfly_fwd(e[0][k2], e[1][k2], e[2][k2], e[3][k2], tw_get(tw, (j + k2 * q16) << (2 * PS)));
    const f32x2 w1 = tw_get(tw, j << (2 * PS + 2));
#pragma unroll
    for (int k1 = 0; k1 < 4; ++k1) bfly_fwd(e[k1][0], e[k1][1], e[k1][2], e[k1][3], w1);
}
template <int PS> __device__ __forceinline__ void inv2_regs(f32x2 (&e)[4][4], const LAS f32x2* tw, int j) {
    constexpr int q16 = (NFFT >> (2 * PS)) / 16;
    f32x2 w1 = tw_get(tw, j << (2 * PS + 2)); w1.y = -w1.y;
#pragma unroll
    for (int k1 = 0; k1 < 4; ++k1) bfly_inv(e[k1][0], e[k1][1], e[k1][2], e[k1][3], w1);
#pragma unroll
    for (int k2 = 0; k2 < 4; ++k2) { f32x2 w = tw_get(tw, (j + k2 * q16) << (2 * PS)); w.y = -w.y; bfly_inv(e[0][k2], e[1][k2], e[2][k2], e[3][k2], w); }
}
template <int PS, bool INV> __device__ __forceinline__ void fft_pass2_lds(LAS f32x2* X, const LAS f32x2* tw, int tid) {
    constexpr int lq = 10 - 2 * PS;
#pragma unroll
    for (int w = tid; w < 1024; w += 512) {
        const int j = w & ((1 << lq) - 1), base = ((w >> lq) << (lq + 4)) + j;
        f32x2 e[4][4];
#pragma unroll
        for (int k = 0; k < 16; ++k) e[k >> 2][k & 3] = X[PADI(base + (k << lq))];
        if (INV) inv2_regs<PS>(e, tw, j); else fwd2_regs<PS>(e, tw, j);
#pragma unroll
        for (int k = 0; k < 16; ++k) X[PADI(base + (k << lq))] = e[k >> 2][k & 3];
    }
    __syncthreads();
}
__device__ __forceinline__ void kf_unit(const float* filtT, f32x2* KF, int c, LAS unsigned char* lds, int tid) {
    const LAS f32x2* tw = (const LAS f32x2*)(lds + LDS_TW_OFF);
    LAS f32x2* X = (LAS f32x2*)lds;
    const float* hf = filtT + (size_t)c * SEQ; const float* hb = filtT + (size_t)(HYW + c) * SEQ;
    for (int n = tid; n < SEQ; n += 512) { X[PADI(n)] = (f32x2){hf[n], 0.f}; X[PADI(SEQ + n)] = (f32x2){n == 0 ? 0.f : hb[SEQ - n], 0.f}; }
    __syncthreads();
    fft_pass2_lds<0, false>(X, tw, tid); fft_pass2_lds<2, false>(X, tw, tid); fft_pass2_lds<4, false>(X, tw, tid);
    f32x2* o = KF + (size_t)c * NFFT;
    for (int w = tid; w < 4096; w += 512) { const int p0 = PADI(4 * w); f32x2 a = X[p0], b = X[p0 + 1], cc = X[p0 + 2], d = X[p0 + 3];
        bfly_fwd1(a, b, cc, d); const float sc = 1.f / (float)NFFT;
        *(f32x4*)(o + 4 * w) = (f32x4){a.x * sc, a.y * sc, b.x * sc, b.y * sc}; *(f32x4*)(o + 4 * w + 2) = (f32x4){cc.x * sc, cc.y * sc, d.x * sc, d.y * sc}; }
    __syncthreads();
}
__device__ __forceinline__ void fftconv_units(bf16_t* VT, const f32x2* KF, int nunits, int bid, int G, LAS unsigned char* lds, int tid) {
    LAS f32x2* X = (LAS f32x2*)lds; const LAS f32x2* tw = (const LAS f32x2*)(lds + LDS_TW_OFF);
    const int w2 = 2 * tid;
    unsigned pre0[8], pre1[8];
    if (bid < nunits) { const bf16_t* s0 = VT + ((size_t)(bid >> 2) * NB + 2 * (bid & 3)) * SEQ;
#pragma unroll
        for (int k = 0; k < 8; ++k) { pre0[k] = *(const unsigned*)(s0 + w2 + (k << 10)); pre1[k] = *(const unsigned*)(s0 + SEQ + w2 + (k << 10)); } }
    for (int u = bid; u < nunits; u += G) {
        const int c = u >> 2, pair = u & 3;
        bf16_t* s0 = VT + ((size_t)c * NB + 2 * pair) * SEQ; bf16_t* s1 = s0 + SEQ;
        { f32x2 ea[4][4], eb[4][4];
#pragma unroll
          for (int k = 0; k < 8; ++k) { ea[k >> 2][k & 3] = (f32x2){bflo(pre0[k]), bflo(pre1[k])}; eb[k >> 2][k & 3] = (f32x2){bfhi(pre0[k]), bfhi(pre1[k])}; }
#pragma unroll
          for (int k = 8; k < 16; ++k) { ea[k >> 2][k & 3] = (f32x2){0.f, 0.f}; eb[k >> 2][k & 3] = (f32x2){0.f, 0.f}; }
          fwd2_regs<0>(ea, tw, w2); fwd2_regs<0>(eb, tw, w2 + 1);
#pragma unroll
          for (int k = 0; k < 16; ++k) { const int pi = PADI(w2 + (k << 10)); *(LAS f32x4*)(X + pi) = (f32x4){ea[k >> 2][k & 3].x, ea[k >> 2][k & 3].y, eb[k >> 2][k & 3].x, eb[k >> 2][k & 3].y}; } }
        __syncthreads();
        fft_pass2_lds<2, false>(X, tw, tid); fft_pass2_lds<4, false>(X, tw, tid);
        const f32x2* kf = KF + (size_t)c * NFFT;
#pragma unroll 2
        for (int w = tid; w < 4096; w += 512) { const int p0 = PADI(4 * w); f32x2 a = X[p0], b = X[p0 + 1], cc = X[p0 + 2], d = X[p0 + 3];
            const f32x4 k01 = *(const f32x4*)(kf + 4 * w), k23 = *(const f32x4*)(kf + 4 * w + 2);
            bfly_fwd1(a, b, cc, d);
            a = cmul(a, (f32x2){k01[0], k01[1]}); b = cmul(b, (f32x2){k01[2], k01[3]}); cc = cmul(cc, (f32x2){k23[0], k23[1]}); d = cmul(d, (f32x2){k23[2], k23[3]});
            bfly_inv1(a, b, cc, d);
            X[p0] = a; X[p0 + 1] = b; X[p0 + 2] = cc; X[p0 + 3] = d; }
        __syncthreads();
        if (u + G < nunits) { const int un = u + G; const bf16_t* n0 = VT + ((size_t)(un >> 2) * NB + 2 * (un & 3)) * SEQ;
#pragma unroll
            for (int k = 0; k < 8; ++k) { pre0[k] = *(const unsigned*)(n0 + w2 + (k << 10)); pre1[k] = *(const unsigned*)(n0 + SEQ + w2 + (k << 10)); } }
        fft_pass2_lds<4, true>(X, tw, tid); fft_pass2_lds<2, true>(X, tw, tid);
        { f32x2 ea[4][4], eb[4][4];
#pragma unroll
          for (int k = 0; k < 16; ++k) { const f32x4 v = *(const LAS f32x4*)(X + PADI(w2 + (k << 10))); ea[k >> 2][k & 3] = (f32x2){v[0], v[1]}; eb[k >> 2][k & 3] = (f32x2){v[2], v[3]}; }
          inv2_regs<0>(ea, tw, w2); inv2_regs<0>(eb, tw, w2 + 1);
#pragma unroll
          for (int k = 0; k < 8; ++k) { *(unsigned*)(s0 + w2 + (k << 10)) = pk2(ea[k >> 2][k & 3].x, eb[k >> 2][k & 3].x); *(unsigned*)(s1 + w2 + (k << 10)) = pk2(ea[k >> 2][k & 3].y, eb[k >> 2][k & 3].y); } }
        __syncthreads();
    }
}
struct SC8 { float v[8]; };
constexpr int LDS_CW_OFF = 98304;
__device__ __forceinline__ void stage_conv_weights(const float* cw, const float* cb, LAS unsigned char* lds, int tid) {
    LAS float* d = (LAS float*)(lds + LDS_CW_OFF);
    for (int e = tid; e < 3 * HYP; e += 512) d[e] = cw[e];
    for (int e = tid; e < HYP; e += 512) d[3 * HYP + e] = cb[e];
    __syncthreads();
}
__device__ __forceinline__ SC8 short_conv8(const bf16_t* hy0, int t, int len, int col, const LAS float* cwl) {
    const u32x4 z4 = {0u, 0u, 0u, 0u};
    const u32x4 um = t > 0 ? *(const u32x4*)(hy0 + (size_t)(t - 1) * HYP + col) : z4;
    const u32x4 u0 = *(const u32x4*)(hy0 + (size_t)t * HYP + col);
    const u32x4 up = t + 1 < len ? *(const u32x4*)(hy0 + (size_t)(t + 1) * HYP + col) : z4;
    const f32x4 w0a = *(const LAS f32x4*)(cwl + col), w0b = *(const LAS f32x4*)(cwl + col + 4), w1a = *(const LAS f32x4*)(cwl + HYP + col), w1b = *(const LAS f32x4*)(cwl + HYP + col + 4),
                w2a = *(const LAS f32x4*)(cwl + 2 * HYP + col), w2b = *(const LAS f32x4*)(cwl + 2 * HYP + col + 4), ba = *(const LAS f32x4*)(cwl + 3 * HYP + col), bb = *(const LAS f32x4*)(cwl + 3 * HYP + col + 4);
    SC8 r;
#pragma unroll
    for (int e = 0; e < 4; ++e) {
        const unsigned a = um[e], b = u0[e], c = up[e]; const int k = 2 * e;
        const float w0l = k < 4 ? w0a[k & 3] : w0b[k & 3], w1l = k < 4 ? w1a[k & 3] : w1b[k & 3], w2l = k < 4 ? w2a[k & 3] : w2b[k & 3], bl = k < 4 ? ba[k & 3] : bb[k & 3];
        const float w0h = k < 4 ? w0a[(k + 1) & 3] : w0b[(k + 1) & 3], w1h = k < 4 ? w1a[(k + 1) & 3] : w1b[(k + 1) & 3], w2h = k < 4 ? w2a[(k + 1) & 3] : w2b[(k + 1) & 3], bh = k < 4 ? ba[(k + 1) & 3] : bb[(k + 1) & 3];
        r.v[k] = bflo(a) * w0l + bflo(b) * w1l + bflo(c) * w2l + bl;
        r.v[k + 1] = bfhi(a) * w0h + bfhi(b) * w1h + bfhi(c) * w2h + bh;
    }
    return r;
}
__device__ __forceinline__ void hy_pre_unit(const bf16_t* HY, bf16_t* VT, int unit, LAS unsigned char* lds, int tid) {
    const LAS float* cwl = (const LAS float*)(lds + LDS_CW_OFF);
    const int cp = unit & 3, tt = (unit >> 2) & 127, b = unit >> 9, t0 = tt * 64;
    { const int tl = tid >> 3, c8 = (tid & 7) * 8; const bf16_t* hy0 = HY + (size_t)b * SEQ * HYP;
      SC8 x1[2], vv[2];
#pragma unroll
      for (int r = 0; r < 2; ++r) { const int c0 = (cp * 2 + r) * 64; x1[r] = short_conv8(hy0, t0 + tl, SEQ, 512 + c0 + c8, cwl); vv[r] = short_conv8(hy0, t0 + tl, SEQ, 1024 + c0 + c8, cwl); }
#pragma unroll
      for (int r = 0; r < 2; ++r) { LAS float* T = (LAS float*)lds + r * 4160;
#pragma unroll
          for (int e = 0; e < 8; ++e) T[(c8 + e) * 65 + tl] = x1[r].v[e] * vv[r].v[e]; } }
    __syncthreads();
    { const int cl = tid >> 3, t8 = (tid & 7) * 8;
#pragma unroll
      for (int r = 0; r < 2; ++r) { const int c0 = (cp * 2 + r) * 64; bf16_t* o = VT + ((size_t)(c0 + cl) * NB + b) * SEQ + t0 + t8; const LAS float* sp = (const LAS float*)lds + r * 4160 + cl * 65 + t8;
          u32x4 w; w.x = pk2(sp[0], sp[1]); w.y = pk2(sp[2], sp[3]); w.z = pk2(sp[4], sp[5]); w.w = pk2(sp[6], sp[7]); *(u32x4*)o = w; } }
    __syncthreads();
}
__device__ __forceinline__ void hy_post_unit(const bf16_t* HY, const bf16_t* VT, bf16_t* HYO, const float* hb, int unit, LAS unsigned char* lds, int tid) {
    const LAS float* cwl = (const LAS float*)(lds + LDS_CW_OFF);
    LAS float* T = (LAS float*)lds;
    const int ct = unit & 7, tt = (unit >> 3) & 127, b = unit >> 10, t0 = tt * 64, c0 = ct * 64;
    { const int cl = tid >> 3, t8 = (tid & 7) * 8; const bf16_t* o = VT + ((size_t)(c0 + cl) * NB + b) * SEQ + t0 + t8; LAS float* s = T + cl * 65 + t8;
      const u32x4 a = *(const u32x4*)o; s[0] = bflo(a.x); s[1] = bfhi(a.x); s[2] = bflo(a.y); s[3] = bfhi(a.y); s[4] = bflo(a.z); s[5] = bfhi(a.z); s[6] = bflo(a.w); s[7] = bfhi(a.w); }
    __syncthreads();
    { const int tl = tid >> 3, c8 = (tid & 7) * 8; const bf16_t* hy0 = HY + (size_t)b * SEQ * HYP;
      const SC8 x0 = short_conv8(hy0, t0 + tl, SEQ, c0 + c8, cwl), x1 = short_conv8(hy0, t0 + tl, SEQ, 512 + c0 + c8, cwl), vv = short_conv8(hy0, t0 + tl, SEQ, 1024 + c0 + c8, cwl);
      float r[8]; const f32x4 hba = *(const f32x4*)(hb + c0 + c8), hbb = *(const f32x4*)(hb + c0 + c8 + 4);
#pragma unroll
      for (int e = 0; e < 8; ++e) { const float vx = x1.v[e] * vv.v[e]; r[e] = (T[(c8 + e) * 65 + tl] + vx * (e < 4 ? hba[e & 3] : hbb[e & 3])) * x0.v[e]; }
      u32x4 w; w.x = pk2(r[0], r[1]); w.y = pk2(r[2], r[3]); w.z = pk2(r[4], r[5]); w.w = pk2(r[6], r[7]);
      *(u32x4*)(HYO + ((size_t)b * SEQ + t0 + tl) * HYW + c0 + c8) = w; }
    __syncthreads();
}
__device__ __forceinline__ void hy_ctx_unit(const bf16_t* HY, const float* FC, bf16_t* HYO, const float* hb, int unit, LAS unsigned char* lds, int tid) {
    const LAS float* cwl = (const LAS float*)(lds + LDS_CW_OFF);
    LAS float* VX = (LAS float*)lds;
    const int ct = unit & 31, b = unit >> 5, c0 = ct * 16; const bf16_t* hy0 = HY + (size_t)(MLAT + b * CTXL) * HYP;
    { const int s = tid >> 1, c8 = (tid & 1) * 8; const SC8 x1 = short_conv8(hy0, s, CTXL, 512 + c0 + c8, cwl), vv = short_conv8(hy0, s, CTXL, 1024 + c0 + c8, cwl);
#pragma unroll
      for (int e = 0; e < 8; ++e) VX[s * 16 + c8 + e] = x1.v[e] * vv.v[e]; }
    __syncthreads();
    { const int c = tid & 15, tg = tid >> 4; const float* fcf = FC + c0 + c; const float* fcb = FC + 512 + c0 + c;
      for (int t = tg * 8; t < tg * 8 + 8; ++t) {
          float acc = 0.f;
          for (int s = 0; s <= t; ++s) acc += fcf[(size_t)(t - s) * 1024] * VX[s * 16 + c];
          for (int s = t + 1; s < CTXL; ++s) acc += fcb[(size_t)(s - t) * 1024] * VX[s * 16 + c];
          const int col = c0 + c; const bf16_t* hr = hy0 + (size_t)t * HYP + col;
          const float um = t > 0 ? bflo((unsigned)hr[-HYP]) : 0.f, u0 = bflo((unsigned)hr[0]), up = t + 1 < CTXL ? bflo((unsigned)hr[HYP]) : 0.f;
          const float x0 = um * cwl[col] + u0 * cwl[HYP + col] + up * cwl[2 * HYP + col] + cwl[3 * HYP + col];
          HYO[((size_t)MLAT + b * CTXL + t) * HYW + col] = (bf16_t)f2bf((acc + VX[t * 16 + c] * hb[col]) * x0);
      } }
    __syncthreads();
}
__device__ __forceinline__ f32x4 ld4row(const float* p) { return *(const f32x4*)p; }
__device__ __forceinline__ f32x4 ld4row(const bf16_t* p) { const u32x2 w = *(const u32x2*)p; return (f32x4){bflo(w.x), bfhi(w.x), bflo(w.y), bfhi(w.y)}; }
template <bool SRCBF> __device__ __forceinline__ const void* norm_row_ptr(const float* lat, const float* ctxp, const bf16_t* XS, int m) {
    if (SRCBF) return XS + (size_t)m * DM;
    return m < MLAT ? lat + (size_t)m * DM : ctxp + (size_t)(m - MLAT) * DM;
}
template <bool SRCBF> __device__ __forceinline__ void norm_row_load(const void* p, int lane, f32x4 (&v)[4]) {
#pragma unroll
    for (int j = 0; j < 4; ++j) v[j] = SRCBF ? ld4row((const bf16_t*)p + 4 * lane + 256 * j) : ld4row((const float*)p + 4 * lane + 256 * j);
}
template <bool SRCBF> __device__ __forceinline__ void norm_mod_rows(const float* lat, const float* ctxp, const bf16_t* XS, int nrows, const float* gain, const float* shift, const float* scale, bf16_t* H, int gw, int NGW, int lane) {
    const int rpw = (nrows + NGW - 1) / NGW, r0 = gw * rpw, r1 = (r0 + rpw < nrows) ? r0 + rpw : nrows;
    int cb = -1; f32x4 gm[4], shv[4];
    for (int m0 = r0; m0 < r1; m0 += 2) {
        const int m1 = m0 + 1; const bool has1 = m1 < r1; const int m1c = has1 ? m1 : m0;
        f32x4 v0[4], v1[4];
        if (SRCBF) {
#pragma unroll
            for (int j = 0; j < 4; ++j) { v0[j] = ld4row(XS + (size_t)m0 * DM + 4 * lane + 256 * j); v1[j] = ld4row(XS + (size_t)m1c * DM + 4 * lane + 256 * j); }
        } else {
            const float* src0 = m0 < MLAT ? lat + (size_t)m0 * DM : ctxp + (size_t)(m0 - MLAT) * DM; const float* src1 = m1c < MLAT ? lat + (size_t)m1c * DM : ctxp + (size_t)(m1c - MLAT) * DM;
#pragma unroll
            for (int j = 0; j < 4; ++j) { v0[j] = ld4row(src0 + 4 * lane + 256 * j); v1[j] = ld4row(src1 + 4 * lane + 256 * j); }
        }
#pragma unroll
        for (int r = 0; r < 2; ++r) {
            if (r == 1 && !has1) break;
            const int m = r ? m1 : m0; const int bidx = m < MLAT ? (m >> 13) : 8;
            if (bidx != cb) { cb = bidx;
#pragma unroll
                for (int j = 0; j < 4; ++j) { const int col = 4 * lane + 256 * j; gm[j] = *(const f32x4*)(gain + col) * (*(const f32x4*)(scale + (size_t)bidx * NMODV + col) + 1.f); shv[j] = *(const f32x4*)(shift + (size_t)bidx * NMODV + col); } }
            float ss = 0.f;
#pragma unroll
            for (int j = 0; j < 4; ++j) { const f32x4 v = r ? v1[j] : v0[j]; ss += (v[0] * v[0] + v[1] * v[1]) + (v[2] * v[2] + v[3] * v[3]); }
            const float rstd = __builtin_amdgcn_rsqf(wave_sum(ss, lane) * (1.f / DM) + EPS);
#pragma unroll
            for (int j = 0; j < 4; ++j) { const f32x4 v = r ? v1[j] : v0[j]; const int col = 4 * lane + 256 * j;
                const f32x4 y = v * rstd * gm[j] + shv[j]; u32x2 w; w.x = pk2(y[0], y[1]); w.y = pk2(y[2], y[3]); *(u32x2*)(H + (size_t)m * DM + col) = w; }
        }
    }
}
__device__ __forceinline__ void final_norm_rows(const bf16_t* XS, float* X, const float* gain, int gw, int NGW, int lane) {
    const int rpw = (MLAT + NGW - 1) / NGW, r0 = gw * rpw, r1 = (r0 + rpw < MLAT) ? r0 + rpw : MLAT;
    f32x4 gv[4];
#pragma unroll
    for (int j = 0; j < 4; ++j) gv[j] = *(const f32x4*)(gain + 4 * lane + 256 * j);
    for (int m0 = r0; m0 < r1; m0 += 2) {
        const int m1 = m0 + 1; const bool has1 = m1 < r1; const int m1c = has1 ? m1 : m0;
        f32x4 v0[4], v1[4];
#pragma unroll
        for (int j = 0; j < 4; ++j) { v0[j] = ld4row(XS + (size_t)m0 * DM + 4 * lane + 256 * j); v1[j] = ld4row(XS + (size_t)m1c * DM + 4 * lane + 256 * j); }
#pragma unroll
        for (int r = 0; r < 2; ++r) {
            if (r == 1 && !has1) break;
            float* dst = X + (size_t)(r ? m1 : m0) * DM; float ss = 0.f;
#pragma unroll
            for (int j = 0; j < 4; ++j) { const f32x4 v = r ? v1[j] : v0[j]; ss += (v[0] * v[0] + v[1] * v[1]) + (v[2] * v[2] + v[3] * v[3]); }
            const float rstd = __builtin_amdgcn_rsqf(wave_sum(ss, lane) * (1.f / DM) + EPS);
#pragma unroll
            for (int j = 0; j < 4; ++j) { const f32x4 v = r ? v1[j] : v0[j]; *(f32x4*)(dst + 4 * lane + 256 * j) = v * rstd * gv[j]; }
        }
    }
}
__device__ __forceinline__ bf16_t* qk_item_ptr(bf16_t* Q, bf16_t* Kp, long it, int l16, int& m, int& hr) {
    m = (int)(it >> 1); hr = 8 + (int)(it & 1);
    const size_t krow = m < MLAT ? (size_t)(m >> 13) * KEYS + CTXL + (m & 8191) : (size_t)((m - MLAT) >> 8) * KEYS + ((m - MLAT) & 255);
    return Kp + krow * 256 + (hr - 8) * 128 + l16 * 8;
}
__device__ __forceinline__ void qk_rows(bf16_t* Q, bf16_t* Kp, const float* qg, const float* kg, const f32x2* rope, int gw, int NGW, int lane) {
    const int l16 = lane & 15, sub = lane >> 4; const long total = (long)MALL * 2, step = (long)NGW * 4;
    const f32x4 kga = *(const f32x4*)(kg + l16 * 8), kgb = *(const f32x4*)(kg + l16 * 8 + 4); (void)qg;
    for (long it0 = (long)gw * 4 + sub; it0 < total; it0 += 4 * step) {
        bf16_t* ptr[4]; int mm[4], hh[4]; u32x4 w[4];
#pragma unroll
        for (int r = 0; r < 4; ++r) { const long it = it0 + r * step; const long itc = it < total ? it : it0; ptr[r] = qk_item_ptr(Q, Kp, itc, l16, mm[r], hh[r]); w[r] = *(const u32x4*)ptr[r]; }
#pragma unroll
        for (int r = 0; r < 4; ++r) {
            const bool valid = (it0 + r * step) < total;
            const int m = mm[r]; const bool lat = m < MLAT;
            float v[8];
#pragma unroll
            for (int e = 0; e < 4; ++e) { v[2 * e] = bflo(w[r][e]); v[2 * e + 1] = bfhi(w[r][e]); }
            float ss = 0.f;
#pragma unroll
            for (int e = 0; e < 8; ++e) ss += v[e] * v[e];
            ss += shx(ss, 1, lane); ss += shx(ss, 2, lane); ss += shx(ss, 4, lane); ss += shx(ss, 8, lane);
            const float rstd = __builtin_amdgcn_rsqf(ss * (1.f / 128.f) + EPS);
#pragma unroll
            for (int e = 0; e < 8; ++e) v[e] = v[e] * rstd * (e < 4 ? kga[e & 3] : kgb[e & 3]);
            if (lat) { const f32x2* rp = rope + (size_t)(m & 8191) * 64 + l16 * 4;
#pragma unroll
                for (int e = 0; e < 4; ++e) { const f32x2 cs = rp[e]; const float a = v[2 * e], b = v[2 * e + 1]; v[2 * e] = a * cs.x - b * cs.y; v[2 * e + 1] = a * cs.y + b * cs.x; } }
            u32x4 o; o.x = pk2(v[0], v[1]); o.y = pk2(v[2], v[3]); o.z = pk2(v[4], v[5]); o.w = pk2(v[6], v[7]);
            if (valid) *(u32x4*)ptr[r] = o;
        }
    }
}
#define GEMM_RUN(EPI, Aptr, Btptr, Mrows, Ncols, Kdim, Eobj) do { pg8::Gemm g_{(const pg8::bf16_t*)(Aptr), (const pg8::bf16_t*)(Btptr), (Mrows), (Ncols), (Kdim)}; pg8::StaticOrder S_; S_.init((Mrows), (Ncols), G, bid); \
    pg8::gemm_phase<EPI, pg8::StaticOrder, true, true>(lds, g_, S_, (Eobj), tid); } while (0)

__device__ __forceinline__ Params kparams() {
#if defined(__HIP_DEVICE_COMPILE__)
    auto q = __builtin_amdgcn_kernarg_segment_ptr(); asm volatile("" : "+s"(q)); return *(const __attribute__((address_space(4))) Params*)q;
#else
    return Params{};
#endif
}
#define PH_BEGIN() const Params p = kparams(); unsigned char* ws = p.ws; (void)ws
__global__ void __launch_bounds__(512, 2) fwd_megakernel(Params p_unused) {
    extern __shared__ __attribute__((aligned(16))) unsigned char smem[];
    cg::grid_group grid = cg::this_grid();
    LAS unsigned char* lds = (LAS unsigned char*)smem;
    const int wave0 = __builtin_amdgcn_readfirstlane((int)threadIdx.x >> 6);
    unsigned xcc_id;
    { const int t0_ = (wave0 << 6) | lane_fresh();
      if (t0_ < 2) ((volatile LAS unsigned*)(lds + LDS_CTL_OFF))[t0_] = 0u;
      for (int k = t0_; k < 2048; k += 512) { float sn, cs; sincospif((float)k * (1.f / 8192.f), &sn, &cs); ((LAS f32x2*)(lds + LDS_TW_OFF))[k] = (f32x2){cs, -sn}; }
      __syncthreads();
      XcdBarrier xb0 = xcd_barrier_post((unsigned*)(kparams().ws + WS_BAR), (volatile LAS unsigned*)(lds + LDS_CTL_OFF), t0_); xcc_id = xb0.x; }
#define GRID_BAR() do { XcdBarrier b_; b_.tid = (wave0 << 6) | lane_fresh(); b_.bar = (unsigned*)(kparams().ws + WS_BAR); b_.x = xcc_id; b_.st = (volatile LAS unsigned*)(lds + LDS_CTL_OFF); xcd_barrier(b_); } while (0)
#define TID_VARS() const int lane = lane_fresh(), tid = (wave0 << 6) | lane, wave = wave0; int G = gridDim.x, bid = blockIdx.x; asm volatile("" : "+s"(G), "+s"(bid)); const int gw = bid * 8 + wave, NGW = G * 8; (void)lane; (void)gw; (void)NGW
    { PH_BEGIN(); TID_VARS();
      phase_weights(p, lds, gw, NGW, wave, lane);
      __syncthreads(); }
    { PH_BEGIN(); TID_VARS();
      for (int u = bid; u < 192; u += G) mod_unit(p, u, lds, tid); }
    { PH_BEGIN(); TID_VARS(); float* filtT = (float*)(ws + WS_FILT); float* filtC = (float*)(ws + WS_FILTC);
      int staged = -1;
      for (int u = bid; u < 2 * 512 + 16; u += G) {
        { const int lf = (u < 1024) ? (u >> 9) : 0; if (lf != staged) { filter_stage_weights(p, lf, lds, tid); staged = lf; } }
        if (u < 1024) filter_unit(p, u >> 9, SEQ, (u & 511) * 16, filtT + (size_t)(u >> 9) * 1024 * SEQ, true, lds, tid);
        else filter_unit(p, 0, CTXL, (u - 1024) * 16, filtC, false, lds, tid);
      } }
    { PH_BEGIN(); TID_VARS(); f32x2* rope = (f32x2*)(ws + WS_ROPE);
      for (int e = bid * 512 + tid; e < SEQ * 64; e += G * 512) { const int t = e >> 6, i = e & 63; const float pos = (float)(i < 32 ? (t >> 6) : (t & 63));
        const float inv = powf(10000.f, -(float)(2 * (i & 31)) * (1.f / 64.f)); float s, c; sincosf(pos * inv, &s, &c); rope[e] = (f32x2){c, s}; } }
    grid.sync();
    if (((wave0 << 6) | lane_fresh()) == 0) { unsigned nloc, nx; xcd_barrier_complete((unsigned*)(kparams().ws + WS_BAR), xcc_id, nloc, nx); ((volatile LAS unsigned*)(lds + LDS_CTL_OFF))[0] = nloc; ((volatile LAS unsigned*)(lds + LDS_CTL_OFF))[1] = nx; }
    __syncthreads();

    for (int l = 0; l < DEPTH; ++l) {
        asm volatile("" : "+s"(l));
        { PH_BEGIN(); TID_VARS(); const float* modl = (const float*)(ws + WS_MOD) + (size_t)l * 9 * NMODV;
          if (l == 0) for (int c = bid; c < HYW; c += G) kf_unit((const float*)(ws + WS_FILT) + (size_t)l * 1024 * SEQ, (f32x2*)(ws + WS_KF), c, lds, tid);
          if (l == 0) norm_mod_rows<false>(p.x, p.ctx, nullptr, MALL, p.norm_mix + l * DM, modl + 0 * DM, modl + 1 * DM, (bf16_t*)(ws + WS_H), gw, NGW, lane);
          else norm_mod_rows<true>(nullptr, nullptr, (const bf16_t*)(ws + WS_XS), MALL, p.norm_mix + l * DM, modl + 0 * DM, modl + 1 * DM, (bf16_t*)(ws + WS_H), gw, NGW, lane); }
        GRID_BAR();
        { PH_BEGIN(); TID_VARS(); const unsigned char* wb = ws + WS_W + (size_t)l * WL_STRIDE;
          pg8::EpiIn E{(bf16_t*)(ws + WS_Q), (bf16_t*)(ws + WS_K), (bf16_t*)(ws + WS_V), (bf16_t*)(ws + WS_HY), (bf16_t*)p.out, (bf16_t*)(ws + WS_G)}; GEMM_RUN(pg8::EpiIn, ws + WS_H, wb + WL_IN, MALL, PROJ, DM, E); }
        GRID_BAR();
        { PH_BEGIN(); TID_VARS();
          qk_rows((bf16_t*)(ws + WS_Q), (bf16_t*)(ws + WS_K), p.q_norm + l * 128, p.k_norm + l * 128, (const f32x2*)(ws + WS_ROPE), gw, NGW, lane);
          stage_conv_weights(p.conv_w + (size_t)l * 3 * HYP, p.conv_b + (size_t)l * HYP, lds, tid);
          for (int u = bid; u < NB * 128 * 4; u += G) hy_pre_unit((const bf16_t*)(ws + WS_HY), (bf16_t*)(ws + WS_H), u, lds, tid); }
        GRID_BAR();
        { PH_BEGIN(); TID_VARS();
          const attn::bf16* Qa = (const attn::bf16*)(ws + WS_Q); const attn::bf16* Ka = (const attn::bf16*)(ws + WS_K); const attn::bf16* Va = (const attn::bf16*)(ws + WS_V);
          for (int i = 0; bid + i * G < 2048; ++i) {
            int u = bid + i * G;
            if (G == 256) { const int xcd = bid & 7, j = bid >> 3; u = ((xcd * 2 + (i >> 2)) << 7) + ((i & 3) << 5) + j; }
            const int qb = u & 31, g4 = (u >> 5) & 3, kvh = (u >> 7) & 1, b = u >> 8, h = kvh * 4 + g4;
            const attn::bf16* Qp = Qa + ((size_t)b * SEQ + qb * 256) * DM + h * 128;
            attn::attn_dense_body<attn::bf16>(Qp, Ka + (size_t)b * KEYS * 256 + kvh * 128, Va + (size_t)b * KEYS * 256 + kvh * 128, (attn::bf16*)Qp, KEYS, (char*)smem, (wave0 << 6) | lane_fresh(), p.q_norm + l * 128, (const f32x2*)(ws + WS_ROPE) + (size_t)qb * 256 * 64);
            __syncthreads();
          }
          if (l == 0) for (int u = bid; u < 64; u += G) {
            const int h = u & 7, b = u >> 3, kvh = h >> 2;
            const attn::bf16* Qp = Qa + ((size_t)MLAT + b * CTXL) * DM + h * 128;
            attn::attn_dense_body<attn::bf16>(Qp, Ka + (size_t)b * KEYS * 256 + kvh * 128, Va + (size_t)b * KEYS * 256 + kvh * 128, (attn::bf16*)Qp, CTXL, (char*)smem, (wave0 << 6) | lane_fresh(), p.q_norm + l * 128, (const f32x2*)nullptr);
            __syncthreads();
          } }
        { PH_BEGIN(); TID_VARS();
          fftconv_units((bf16_t*)(ws + WS_H), (const f32x2*)(ws + WS_KF), HYW * 4, bid, G, lds, tid); }
        GRID_BAR();
        { PH_BEGIN(); TID_VARS();
          stage_conv_weights(p.conv_w + (size_t)l * 3 * HYP, p.conv_b + (size_t)l * HYP, lds, tid);
          for (int u = bid; u < NB * 128 * 8; u += G) hy_post_unit((const bf16_t*)(ws + WS_HY), (const bf16_t*)(ws + WS_H), (bf16_t*)(ws + WS_HYO), p.hbias + (size_t)l * HYW, u, lds, tid);
          if (l == 0) for (int u = bid; u < 256; u += G) hy_ctx_unit((const bf16_t*)(ws + WS_HY), (const float*)(ws + WS_FILTC), (bf16_t*)(ws + WS_HYO), p.hbias + (size_t)l * HYW, u, lds, tid); }
        GRID_BAR();
        { PH_BEGIN(); TID_VARS(); const unsigned char* wb = ws + WS_W + (size_t)l * WL_STRIDE; const int Mmix = (l == DEPTH - 1) ? MLAT : MALL;
          pg8::EpiMerge<false> E{(const bf16_t*)p.out, (const bf16_t*)(ws + WS_G), (bf16_t*)(ws + WS_HY), 0}; GEMM_RUN(pg8::EpiMerge<false>, ws + WS_Q, wb + WL_OA, Mmix, DM, DM, E); }
        { PH_BEGIN(); TID_VARS(); const unsigned char* wb = ws + WS_W + (size_t)l * WL_STRIDE; const int Mmix = (l == DEPTH - 1) ? MLAT : MALL;
          pg8::EpiMerge<true> E{(const bf16_t*)p.out, (const bf16_t*)(ws + WS_G), (bf16_t*)(ws + WS_HY), DM}; GEMM_RUN(pg8::EpiMerge<true>, ws + WS_HYO, wb + WL_OH, Mmix, DM, HYW, E); }
        GRID_BAR();
        { PH_BEGIN(); TID_VARS(); const unsigned char* wb = ws + WS_W + (size_t)l * WL_STRIDE; const int Mmix = (l == DEPTH - 1) ? MLAT : MALL; const float* modl = (const float*)(ws + WS_MOD) + (size_t)l * 9 * NMODV;
          if (l == 0) { pg8::EpiResid<true> E{p.x, p.ctx, (bf16_t*)(ws + WS_XS), modl + 2 * DM}; GEMM_RUN(pg8::EpiResid<true>, ws + WS_HY, wb + WL_OUT, Mmix, DM, DM, E); }
          else { pg8::EpiResid<false> E{nullptr, nullptr, (bf16_t*)(ws + WS_XS), modl + 2 * DM}; GEMM_RUN(pg8::EpiResid<false>, ws + WS_HY, wb + WL_OUT, Mmix, DM, DM, E); } }
        GRID_BAR();
        { PH_BEGIN(); TID_VARS(); const int Mmix = (l == DEPTH - 1) ? MLAT : MALL; const float* modl = (const float*)(ws + WS_MOD) + (size_t)l * 9 * NMODV;
          norm_mod_rows<true>(nullptr, nullptr, (const bf16_t*)(ws + WS_XS), Mmix, p.norm_ffn + l * DM, modl + 3 * DM, modl + 4 * DM, (bf16_t*)(ws + WS_H), gw, NGW, lane); }
        GRID_BAR();
        { PH_BEGIN(); TID_VARS(); const unsigned char* wb = ws + WS_W + (size_t)l * WL_STRIDE; const int Mmix = (l == DEPTH - 1) ? MLAT : MALL;
          pg8::EpiSwiglu E{(bf16_t*)(ws + WS_ACT)}; GEMM_RUN(pg8::EpiSwiglu, ws + WS_H, wb + WL_GU, Mmix, 2 * DFF, DM, E); }
        GRID_BAR();
        { PH_BEGIN(); TID_VARS(); const unsigned char* wb = ws + WS_W + (size_t)l * WL_STRIDE; const int Mmix = (l == DEPTH - 1) ? MLAT : MALL; const float* modl = (const float*)(ws + WS_MOD) + (size_t)l * 9 * NMODV;
          pg8::EpiResid<false> E{nullptr, nullptr, (bf16_t*)(ws + WS_XS), modl + 5 * DM}; GEMM_RUN(pg8::EpiResid<false>, ws + WS_ACT, wb + WL_DN, Mmix, DM, DFF, E);
          if (l == 0) { const int nwg = (MALL / 256) * (DM / 256), first = (nwg % G) ? nwg % G : 0;
            if (bid >= first) { __syncthreads(); for (int c = bid - first; c < HYW; c += G - first) kf_unit((const float*)(ws + WS_FILT) + (size_t)1024 * SEQ, (f32x2*)(ws + WS_KF), c, lds, tid); } } }
        GRID_BAR();
    }
    { PH_BEGIN(); TID_VARS();
      final_norm_rows((const bf16_t*)(ws + WS_XS), p.out, p.norm_final, gw, NGW, lane); }
}

extern "C" void kernel_launch(void* const* d_in, const int* in_sizes, int n_in, void* d_out, int out_size, void* d_ws, size_t ws_size, hipStream_t stream) {
    static int grid_blocks = 0;
    if (grid_blocks == 0) {
        if (n_in != 28 || in_sizes[0] != MLAT * DM || out_size != MLAT * DM || ws_size < WS_END) {
            fprintf(stderr, "kernel_launch: shape/workspace mismatch: n_in %d in0 %d out %d ws %zu (need >= %zu)\n", n_in, n_in > 0 ? in_sizes[0] : -1, out_size, ws_size, (size_t)WS_END); grid_blocks = -1; return; }
        int dev = 0, cus = 0, per_cu = 0;
        hipGetDevice(&dev); hipDeviceGetAttribute(&cus, hipDeviceAttributeMultiprocessorCount, dev);
        if (hipFuncSetAttribute((const void*)fwd_megakernel, hipFuncAttributeMaxDynamicSharedMemorySize, LDS_BYTES) != hipSuccess) { fprintf(stderr, "kernel_launch: hipFuncSetAttribute failed\n"); grid_blocks = -1; return; }
        if (hipOccupancyMaxActiveBlocksPerMultiprocessor(&per_cu, (const void*)fwd_megakernel, 512, LDS_BYTES) != hipSuccess || per_cu < 1) { fprintf(stderr, "kernel_launch: occupancy query says %d\n", per_cu); per_cu = 1; }
        (void)hipGetLastError();
        grid_blocks = cus * 1;
    }
    if (grid_blocks < 0) return;
    if (hipMemsetAsync((char*)d_ws + WS_BAR, 0, WS_BAR_BYTES, stream) != hipSuccess) { fprintf(stderr, "kernel_launch: memset of barrier words failed\n"); return; }
    Params p{};
    const float** pp = (const float**)&p;
    for (int i = 0; i < 28; ++i) pp[i] = (const float*)d_in[i];
    p.out = (float*)d_out; p.ws = (unsigned char*)d_ws;
    void* args[] = {&p};
    hipError_t e = hipLaunchCooperativeKernel((const void*)fwd_megakernel, dim3(grid_blocks), dim3(512), args, LDS_BYTES, stream);
    if (e != hipSuccess) fprintf(stderr, "cooperative launch failed: %s (grid %d)\n", hipGetErrorString(e), grid_blocks);
}
```

```cpp
#include <hip/hip_runtime.h>
#include <hip/hip_bf16.h>
#include <hip/hip_cooperative_groups.h>
#include <cstdio>
#include <cstdint>
namespace cg = cooperative_groups;

constexpr int DM = 1024, NB = 8, SEQ = 8192, CTXL = 256, DEPTH = 2;
constexpr int MLAT = NB * SEQ, MCTX = NB * CTXL, MALL = MLAT + MCTX;
constexpr int PROJ = 5120, DFF = 2816, HYW = 512, HYP = 1536, GATEW = 2048, NMODV = 6 * DM;
constexpr int KEYS = CTXL + SEQ;
constexpr int NFFT = 16384;
constexpr float EPS = 1e-6f;
constexpr size_t MiB = 1u << 20;
constexpr size_t WS_MOD = 0;
constexpr size_t WS_TW = 512 * 1024;
constexpr size_t WS_ROPE = 1 * MiB;
constexpr size_t WS_W = 6 * MiB;
constexpr size_t WL_IN = 0, WL_OA = WL_IN + (size_t)PROJ * DM * 2, WL_OH = WL_OA + (size_t)DM * DM * 2, WL_OUT = WL_OH + (size_t)DM * HYW * 2,
                 WL_GU = WL_OUT + (size_t)DM * DM * 2, WL_DN = WL_GU + (size_t)2 * DFF * DM * 2, WL_STRIDE = WL_DN + (size_t)DM * DFF * 2;
constexpr size_t WS_KF = 70 * MiB;
constexpr size_t WS_H = 134 * MiB;
constexpr size_t WS_Q = 266 * MiB;
constexpr size_t WS_K = 398 * MiB;
constexpr size_t WS_V = 431 * MiB;
constexpr size_t WS_HYO = 398 * MiB;
constexpr size_t WS_HY = 464 * MiB;
constexpr size_t WS_G = 662 * MiB;
constexpr size_t WS_XS = 670 * MiB;
constexpr size_t WS_ACT = 266 * MiB;
constexpr size_t WS_CTXS = 926 * MiB;
constexpr size_t WS_FILT = 934 * MiB;
constexpr size_t WS_FILTC = 998 * MiB;
constexpr size_t WS_END = 1000 * MiB;
static_assert(WS_W + 2 * WL_STRIDE <= WS_KF && WS_H + (size_t)MALL * DM * 2 <= WS_Q && WS_Q + (size_t)MALL * DM * 2 <= WS_K && WS_K + (size_t)NB * KEYS * 256 * 2 <= WS_V &&
              WS_V + (size_t)NB * KEYS * 256 * 2 <= WS_HY && WS_HYO + (size_t)MALL * HYW * 2 <= WS_HY && WS_HY + (size_t)MALL * HYP * 2 <= WS_G && WS_G + (size_t)MCTX * GATEW * 2 <= WS_XS && WS_XS + (size_t)MALL * DM * 2 <= WS_CTXS && (size_t)MLAT * GATEW * 2 <= (size_t)MLAT * DM * 4 &&
              WS_ACT + (size_t)MALL * DFF * 2 <= WS_G && (size_t)HYW * NB * SEQ * 4 <= (size_t)MALL * DM * 2, "ws map");

#define LAS __attribute__((address_space(3)))
typedef float f32x4 __attribute__((ext_vector_type(4)));
typedef float f32x2 __attribute__((ext_vector_type(2)));
typedef unsigned u32x4 __attribute__((ext_vector_type(4)));
typedef unsigned u32x2 __attribute__((ext_vector_type(2)));
typedef unsigned short bf16_t;
constexpr int LDS_BYTES = 159744;
constexpr int LDS_TW_OFF = 139264;
constexpr int LDS_CTL_OFF = 155648;
constexpr size_t WS_BAR = 480 * 1024, WS_BAR_BYTES = 16384;

struct Params {
    const float *x, *c, *ctx, *c_ctx, *w_mod, *b_mod, *norm_mix, *w_in, *q_norm, *k_norm, *conv_w, *conv_b, *fw1, *fb1, *fw2, *fb2, *fw3, *fb3, *fw4, *freq, *hbias,
                *w_oa, *w_oh, *w_out, *norm_ffn, *w_gu, *w_dn, *norm_final;
    float* out; unsigned char* ws;
};

__device__ __forceinline__ unsigned f2bf(float f) { unsigned u = __builtin_bit_cast(unsigned, f); return (u + 0x7fffu + ((u >> 16) & 1u)) >> 16; }
__device__ __forceinline__ unsigned pk2(float lo, float hi) { unsigned r; asm("v_cvt_pk_bf16_f32 %0, %1, %2" : "=v"(r) : "v"(lo), "v"(hi)); return r; }
__device__ __forceinline__ float bflo(unsigned w) { return __builtin_bit_cast(float, w << 16); }
__device__ __forceinline__ float bfhi(unsigned w) { return __builtin_bit_cast(float, w & 0xffff0000u); }
__device__ __forceinline__ float shx(float v, int o, int lane) { return __builtin_bit_cast(float, __builtin_amdgcn_ds_bpermute((lane ^ o) << 2, __builtin_bit_cast(int, v))); }
__device__ __forceinline__ float wave_sum(float v, int lane) {
#pragma unroll
    for (int o = 1; o < 64; o <<= 1) v += shx(v, o, lane);
    return v;
}
__device__ __forceinline__ float sigmoidf_(float v) { return __builtin_amdgcn_rcpf(1.f + __expf(-v)); }
__device__ __forceinline__ int lane_fresh() { int t; asm volatile("v_mbcnt_lo_u32_b32 %0, -1, 0\n\tv_mbcnt_hi_u32_b32 %0, -1, %0" : "=v"(t)); return t; }
namespace pg8 {
#define PG8_LAS __attribute__((address_space(3)))
typedef unsigned short bf16_t;
typedef short bf16x8 __attribute__((ext_vector_type(8)));
typedef float f32x4 __attribute__((ext_vector_type(4)));
typedef unsigned u32x4 __attribute__((ext_vector_type(4)));
constexpr int BM = 256, BK = 64, HALF = 128, HTB = HALF * BK * 2  , STAGE_BYTES = 8 * HTB, NXCD = 8, WGM = 8;

__host__ __device__ __forceinline__ int lds_byte(int r, int c) { const int st = (r >> 4) * 2 + (c >> 5), rr = r & 15, cc = c & 31, ob = rr * 64 + cc * 2; return st * 1024 + (ob ^ (((ob >> 9) & 1) << 5)); }
__host__ __device__ __forceinline__ void stage_rc(int b, int& R, int& C) { const int st = b / 1024, sb = b % 1024, swz = sb ^ (((sb >> 9) & 1) << 5); R = (st >> 1) * 16 + swz / 64; C = (st & 1) * 32 + (swz % 64) / 2; }
__host__ __device__ __forceinline__ int perm32(int rho) { const int n = rho >> 4, i = rho & 15; return 8 * (i >> 2) + 4 * n + (i & 3); }

struct Unit { int pm, pn; };
struct Gemm { const bf16_t* A; const bf16_t* Bt; int M, N, K; };

struct StaticOrder {
    int nM, nN, nwg, G, c;
    __host__ __device__ void init(int M, int N, int G_, int c_) { nM = M / BM; nN = N / BM; nwg = nM * nN; G = G_; c = c_; }
    __host__ __device__ bool next(int i, Unit& u) const {
        const long L = (long)i * G + c; if (L >= nwg) return false;
        int wgid = (int)L; { const int q = nwg / NXCD, r = nwg % NXCD, xcd = wgid % NXCD, off = wgid / NXCD; wgid = (xcd < r ? xcd * (q + 1) : r * (q + 1) + (xcd - r) * q) + off; }
        const int nig = WGM * nN, gid = wgid / nig, fm = gid * WGM, gsz = (nM - fm) < WGM ? (nM - fm) : WGM;
        u.pm = fm + ((wgid % nig) % gsz); u.pn = (wgid % nig) / gsz; return true;
    }
    __device__ __forceinline__ void a_ready(const Unit&) const {}
    __device__ __forceinline__ void done(const Unit&) const {}
};

__device__ __forceinline__ unsigned cvt_pk_bf16(float lo, float hi) { unsigned r; asm volatile("v_cvt_pk_bf16_f32 %0, %1, %2" : "=v"(r) : "v"(lo), "v"(hi)); return r; }
typedef float f32x2 __attribute__((ext_vector_type(2)));
template <class Epi, class Sched, bool ALIGN_EPI = false, bool SP2 = false>
__device__ __forceinline__ void gemm_phase(PG8_LAS unsigned char* lds, const Gemm g, const Sched& S, const Epi& E, const int tid_in) {
    const int tid = tid_in, wid = __builtin_amdgcn_readfirstlane(tid >> 6), lane = tid & 63, wr = wid >> 2, wc = wid & 3, fr = lane & 15, fq = lane >> 4;
    const int K = g.K, nt = K / BK;
    unsigned voffA[2], voffB[2];
#pragma unroll
    for (int i = 0; i < 2; ++i) { int R, C; stage_rc(tid * 16 + i * 8192, R, C); const int Rb = Epi::PERM ? ((R & ~31) + perm32(R & 31)) : R;
        voffA[i] = (unsigned)(R * K + C) * 2u; voffB[i] = (unsigned)(Rb * K + C) * 2u; }
    const size_t kstep = (size_t)(BK * 2);
    const size_t hstep = (size_t)HALF * K * 2;
    const size_t tstep = 2 * hstep;
    const unsigned ldsw = (unsigned)wid * 1024u;
    const int aoff = lds_byte(wr * 64 + fr, fq * 8), boff = lds_byte(wc * 32 + fr, fq * 8);
#define PG8_SA(b, h) (((b) * 2 + (h)) * HTB)
#define PG8_SB(b, h) ((4 + (b) * 2 + (h)) * HTB)
#define PG8_STAGE(bufoff, gbase, voff) do { _Pragma("unroll") for (int _i = 0; _i < 2; ++_i) \
        __builtin_amdgcn_global_load_lds((const unsigned*)((const char*)(gbase) + (voff)[_i]), (PG8_LAS unsigned*)(lds + (bufoff) + ldsw + _i * 8192), 16, 0, 0); } while (0)
#define PG8_LDA(dst, b, h) do { _Pragma("unroll") for (int m = 0; m < 4; ++m) _Pragma("unroll") for (int k = 0; k < 2; ++k) dst[m][k] = *(const PG8_LAS bf16x8*)(lds + PG8_SA(b, h) + aoff + m * 2048 + k * 1024); } while (0)
#define PG8_LDB(dst, b, h) do { _Pragma("unroll") for (int n = 0; n < 2; ++n) _Pragma("unroll") for (int k = 0; k < 2; ++k) dst[n][k] = *(const PG8_LAS bf16x8*)(lds + PG8_SB(b, h) + boff + n * 2048 + k * 1024); } while (0)
#define PG8_MMA(ai, bj, At, Bt) do { __builtin_amdgcn_s_setprio(1); _Pragma("unroll") for (int m = 0; m < 4; ++m) _Pragma("unroll") for (int n = 0; n < 2; ++n) _Pragma("unroll") for (int k = 0; k < 2; ++k) \
        acc[ai][bj][m][n] = __builtin_amdgcn_mfma_f32_16x16x32_bf16(Bt[n][k], At[m][k], acc[ai][bj][m][n], 0, 0, 0); __builtin_amdgcn_s_setprio(0); } while (0)
#define PG8_WAIT_V(n) asm volatile("s_waitcnt vmcnt(" #n ")" ::: "memory")
#define PG8_WAIT_L(n) asm volatile("s_waitcnt lgkmcnt(" #n ")" ::: "memory")
#define PG8_BAR __builtin_amdgcn_s_barrier()
#define PG8_SCHED __builtin_amdgcn_sched_barrier(0)
    Unit cur, nxt; int ui = 0;
    if (!S.next(0, cur)) return;
    f32x4 acc[2][2][4][2];
#pragma unroll
    for (int a = 0; a < 2; ++a)
#pragma unroll
        for (int b = 0; b < 2; ++b)
#pragma unroll
            for (int m = 0; m < 4; ++m)
#pragma unroll
                for (int n = 0; n < 2; ++n) acc[a][b][m][n] = (f32x4){0.f, 0.f, 0.f, 0.f};
    bf16x8 At[4][2], B0[2][2], B1[2][2];
    const char* cA = (const char*)g.A + (size_t)cur.pm * tstep; const char* cB = (const char*)g.Bt + (size_t)cur.pn * tstep;
    S.a_ready(cur);
    if constexpr (SP2) {
        PG8_STAGE(PG8_SB(0, 0), cB, voffB); PG8_STAGE(PG8_SB(0, 1), cB + hstep, voffB); PG8_STAGE(PG8_SA(0, 0), cA, voffA); PG8_STAGE(PG8_SA(0, 1), cA + hstep, voffA);
        if (wr == 1) PG8_BAR;
        PG8_WAIT_V(2); PG8_BAR;
        PG8_STAGE(PG8_SB(1, 0), cB + kstep, voffB); PG8_STAGE(PG8_SA(1, 0), cA + kstep, voffA); PG8_STAGE(PG8_SB(1, 1), cB + hstep + kstep, voffB);
        PG8_WAIT_V(6); PG8_BAR;
    } else {
        PG8_STAGE(PG8_SB(0, 0), cB, voffB); PG8_STAGE(PG8_SA(0, 0), cA, voffA); PG8_STAGE(PG8_SB(0, 1), cB + hstep, voffB); PG8_STAGE(PG8_SA(0, 1), cA + hstep, voffA);
        if (wr == 1) PG8_BAR;
        PG8_WAIT_V(4); PG8_BAR;
        PG8_STAGE(PG8_SB(1, 0), cB + kstep, voffB); PG8_STAGE(PG8_SA(1, 0), cA + kstep, voffA); PG8_STAGE(PG8_SB(1, 1), cB + hstep + kstep, voffB);
        PG8_WAIT_V(6); PG8_BAR;
    }
    for (;;) {
        const bool has_next = S.next(ui + 1, nxt);
        const char* nA = has_next ? (const char*)g.A + (size_t)nxt.pm * tstep : cA; const char* nB = has_next ? (const char*)g.Bt + (size_t)nxt.pn * tstep : cB;
        for (int t = 0; t < nt; t += 2) {
            const bool last = (t == nt - 2);
            const char* a1 = cA + (size_t)(t + 1) * kstep;
            const char* a2 = last ? nA : cA + (size_t)(t + 2) * kstep; const char* b2 = last ? nB : cB + (size_t)(t + 2) * kstep;
            const char* a3 = a2 + kstep; const char* b3 = b2 + kstep;
            if (last && has_next) S.a_ready(nxt);
            if constexpr (SP2) {
            PG8_LDB(B0, 0, 0); PG8_LDB(B1, 0, 1); PG8_SCHED; PG8_LDA(At, 0, 0); PG8_STAGE(PG8_SA(1, 1), a1 + hstep, voffA);
            PG8_WAIT_V(8); PG8_WAIT_L(0); PG8_BAR; PG8_MMA(0, 0, At, B0); PG8_MMA(0, 1, At, B1); PG8_BAR; PG8_SCHED;
            PG8_LDA(At, 0, 1); PG8_STAGE(PG8_SB(0, 0), b2, voffB); PG8_STAGE(PG8_SB(0, 1), b2 + hstep, voffB); PG8_STAGE(PG8_SA(0, 0), a2, voffA);
            PG8_WAIT_V(8); PG8_WAIT_L(0); PG8_BAR; PG8_MMA(1, 0, At, B0); PG8_MMA(1, 1, At, B1); PG8_BAR; PG8_SCHED;
            PG8_LDB(B0, 1, 0); PG8_LDB(B1, 1, 1); PG8_SCHED; PG8_LDA(At, 1, 0); PG8_STAGE(PG8_SA(0, 1), a2 + hstep, voffA);
            PG8_WAIT_V(8); PG8_WAIT_L(0); PG8_BAR; PG8_MMA(0, 0, At, B0); PG8_MMA(0, 1, At, B1); PG8_BAR; PG8_SCHED;
            PG8_LDA(At, 1, 1); PG8_STAGE(PG8_SB(1, 0), b3, voffB); PG8_STAGE(PG8_SB(1, 1), b3 + hstep, voffB); PG8_STAGE(PG8_SA(1, 0), a3, voffA);
            PG8_WAIT_V(8); PG8_WAIT_L(0); PG8_BAR; PG8_MMA(1, 0, At, B0); PG8_MMA(1, 1, At, B1); PG8_BAR; PG8_SCHED;
            } else {
            PG8_LDB(B0, 0, 0); PG8_SCHED; PG8_LDA(At, 0, 0); PG8_STAGE(PG8_SA(1, 1), a1 + hstep, voffA);
            PG8_WAIT_L(8); PG8_BAR; PG8_WAIT_L(0); PG8_MMA(0, 0, At, B0); PG8_BAR; PG8_SCHED;
            PG8_LDB(B1, 0, 1); PG8_STAGE(PG8_SB(0, 0), b2, voffB);
            PG8_BAR; PG8_WAIT_L(0); PG8_MMA(0, 1, At, B1); PG8_BAR;
            PG8_LDA(At, 0, 1); PG8_STAGE(PG8_SA(0, 0), a2, voffA);
            PG8_BAR; PG8_WAIT_L(0); PG8_MMA(1, 0, At, B0); PG8_BAR; PG8_SCHED;
            PG8_STAGE(PG8_SB(0, 1), b2 + hstep, voffB);
            PG8_WAIT_V(6); PG8_BAR; PG8_MMA(1, 1, At, B1); PG8_BAR;
            PG8_LDB(B0, 1, 0); PG8_SCHED; PG8_LDA(At, 1, 0); PG8_STAGE(PG8_SA(0, 1), a2 + hstep, voffA);
            PG8_WAIT_L(8); PG8_BAR; PG8_WAIT_L(0); PG8_MMA(0, 0, At, B0); PG8_BAR; PG8_SCHED;
            PG8_LDB(B1, 1, 1); PG8_STAGE(PG8_SB(1, 0), b3, voffB);
            PG8_BAR; PG8_WAIT_L(0); PG8_MMA(0, 1, At, B1); PG8_BAR;
            PG8_LDA(At, 1, 1); PG8_STAGE(PG8_SA(1, 0), a3, voffA);
            PG8_BAR; PG8_WAIT_L(0); PG8_MMA(1, 0, At, B0); PG8_BAR; PG8_SCHED;
            PG8_STAGE(PG8_SB(1, 1), b3 + hstep, voffB);
            PG8_WAIT_V(6); PG8_BAR; PG8_MMA(1, 1, At, B1); PG8_BAR;
            }
        }
        if constexpr (ALIGN_EPI) { if (wr == 0) PG8_BAR; }
        if constexpr (!Epi::AFTER_DRAIN) { E(acc, cur, wr, wc, fr, fq); S.done(cur); }
        if (!has_next) break;
#pragma unroll
        for (int a = 0; a < 2; ++a)
#pragma unroll
            for (int b = 0; b < 2; ++b)
#pragma unroll
                for (int m = 0; m < 4; ++m)
#pragma unroll
                    for (int n = 0; n < 2; ++n) acc[a][b][m][n] = (f32x4){0.f, 0.f, 0.f, 0.f};
        cur = nxt; cA = nA; cB = nB; ++ui;
        if constexpr (ALIGN_EPI) { if (wr == 1) PG8_BAR; }
    }
    PG8_WAIT_V(0);
    if constexpr (!ALIGN_EPI) { if (wr == 0) PG8_BAR; }
    PG8_BAR;
    if constexpr (Epi::AFTER_DRAIN) { E.fused(acc, cur, wr, wc, fr, fq, lds, wid, lane); S.done(cur); }
#undef PG8_SA
#undef PG8_SB
#undef PG8_STAGE
#undef PG8_LDA
#undef PG8_LDB
#undef PG8_MMA
#undef PG8_WAIT_V
#undef PG8_WAIT_L
#undef PG8_BAR
#undef PG8_SCHED
}
}
namespace pg8 {
__device__ __forceinline__ u32x4 pack8(const f32x4 v0, const f32x4 v1) { u32x4 w; w.x = cvt_pk_bf16(v0[0], v0[1]); w.y = cvt_pk_bf16(v0[2], v0[3]); w.z = cvt_pk_bf16(v1[0], v1[1]); w.w = cvt_pk_bf16(v1[2], v1[3]); return w; }
struct EpiIn {
    static constexpr bool PERM = true, AFTER_DRAIN = false;
    bf16_t *Q, *Kp, *Vp, *HY, *Glat, *Gctx;
    __device__ __forceinline__ void operator()(const f32x4 (&acc)[2][2][4][2], const Unit& u, int wr, int wc, int fr, int fq) const {
        const int pn = u.pn, m0 = u.pm * BM; bf16_t* base; int ldc, colt; size_t rowbase = (size_t)m0;
        if (pn < 4) { base = Q; ldc = 1024; colt = pn * 256; }
        else if (pn < 6) { base = (pn == 4) ? Kp : Vp; ldc = 256; colt = 0; rowbase = (m0 < MLAT) ? (size_t)(m0 >> 13) * KEYS + CTXL + (m0 & 8191) : (size_t)((m0 - MLAT) >> 8) * KEYS; }
        else if (pn < 12) { base = HY; ldc = 1536; colt = (pn - 6) * 256; }
        else { const bool lat = m0 < MLAT; base = lat ? Glat : Gctx; ldc = 2048; colt = (pn - 12) * 256; if (!lat) rowbase = (size_t)(m0 - MLAT); }
        const int col0 = colt + wc * 32 + 8 * fq;
#pragma unroll
        for (int ai = 0; ai < 2; ++ai)
#pragma unroll
            for (int m = 0; m < 4; ++m) { bf16_t* rowp = base + (rowbase + (size_t)(wr * 64 + fr + ai * HALF + m * 16)) * ldc + col0;
#pragma unroll
                for (int bj = 0; bj < 2; ++bj) *(u32x4*)(rowp + bj * HALF) = pack8(acc[ai][bj][m][0], acc[ai][bj][m][1]); }
    }
};
template <bool ADD> struct EpiMerge {
    static constexpr bool PERM = true, AFTER_DRAIN = false;
    const bf16_t *Glat, *Gctx; bf16_t* Mg; int goff;
    static __device__ __forceinline__ f32x2 gate2(unsigned gw, f32x2 a) {
        f32x2 t = (f32x2){bflo(gw), bfhi(gw)} * (-1.4426950408889634f);
        t.x = __builtin_amdgcn_exp2f(t.x); t.y = __builtin_amdgcn_exp2f(t.y);
        t = t + 1.0f;
        t.x = __builtin_amdgcn_rcpf(t.x); t.y = __builtin_amdgcn_rcpf(t.y);
        return a * t;
    }
    __device__ __forceinline__ void operator()(const f32x4 (&acc)[2][2][4][2], const Unit& u, int wr, int wc, int fr, int fq) const {
        const int col0 = u.pn * BM + wc * 32 + 8 * fq;
#pragma unroll
        for (int ai = 0; ai < 2; ++ai)
#pragma unroll
            for (int m = 0; m < 4; ++m) { const size_t row = (size_t)(u.pm * BM + wr * 64 + fr + ai * HALF + m * 16);
                const bf16_t* grow = (u.pm * BM < MLAT) ? Glat + row * GATEW : Gctx + (row - MLAT) * GATEW;
#pragma unroll
                for (int bj = 0; bj < 2; ++bj) {
                    const u32x4 g = *(const u32x4*)(grow + goff + col0 + bj * HALF);
                    const f32x4 a0 = acc[ai][bj][m][0], a1 = acc[ai][bj][m][1];
                    f32x2 r0 = gate2(g.x, (f32x2){a0[0], a0[1]}), r1 = gate2(g.y, (f32x2){a0[2], a0[3]}), r2 = gate2(g.z, (f32x2){a1[0], a1[1]}), r3 = gate2(g.w, (f32x2){a1[2], a1[3]});
                    bf16_t* dst = Mg + row * DM + col0 + bj * HALF;
                    if (ADD) { const u32x4 o = *(const u32x4*)dst;
                        r0 = r0 + (f32x2){bflo(o.x), bfhi(o.x)}; r1 = r1 + (f32x2){bflo(o.y), bfhi(o.y)}; r2 = r2 + (f32x2){bflo(o.z), bfhi(o.z)}; r3 = r3 + (f32x2){bflo(o.w), bfhi(o.w)}; }
                    u32x4 w; w.x = cvt_pk_bf16(r0.x, r0.y); w.y = cvt_pk_bf16(r1.x, r1.y); w.z = cvt_pk_bf16(r2.x, r2.y); w.w = cvt_pk_bf16(r3.x, r3.y);
                    *(u32x4*)dst = w; } }
    }
};
template <bool INF32> struct EpiResid {
    static constexpr bool PERM = false, AFTER_DRAIN = false;
    const float *in_lat, *in_ctx; bf16_t* XS; const float* gate;
    __device__ __forceinline__ void operator()(const f32x4 (&acc)[2][2][4][2], const Unit& u, int wr, int wc, int fr, int fq) const {
        const int m0 = u.pm * BM; const bool lat = m0 < MLAT; const int bidx = lat ? (m0 >> 13) : 8;
        const float* xin = lat ? in_lat + (size_t)m0 * DM : in_ctx + (size_t)(m0 - MLAT) * DM; bf16_t* xs = XS + (size_t)m0 * DM;
        const int col0 = u.pn * BM + wc * 32 + 4 * fq; const float* gp = gate + (size_t)bidx * NMODV + col0;
        f32x4 gv[2][2];
#pragma unroll
        for (int bj = 0; bj < 2; ++bj)
#pragma unroll
            for (int n = 0; n < 2; ++n) gv[bj][n] = *(const f32x4*)(gp + bj * HALF + n * 16);
#pragma unroll
        for (int ai = 0; ai < 2; ++ai)
#pragma unroll
            for (int m = 0; m < 4; ++m) { const size_t off = (size_t)(wr * 64 + fr + ai * HALF + m * 16) * DM + col0;
#pragma unroll
                for (int bj = 0; bj < 2; ++bj)
#pragma unroll
                    for (int n = 0; n < 2; ++n) { f32x4 xi;
                        if (INF32) xi = *(const f32x4*)(xin + off + bj * HALF + n * 16);
                        else { const u32x2 w = *(const u32x2*)(xs + off + bj * HALF + n * 16); xi = (f32x4){bflo(w.x), bfhi(w.x), bflo(w.y), bfhi(w.y)}; }
                        const f32x4 xo = xi + gv[bj][n] * acc[ai][bj][m][n]; u32x2 o; o.x = cvt_pk_bf16(xo[0], xo[1]); o.y = cvt_pk_bf16(xo[2], xo[3]);
                        *(u32x2*)(xs + off + bj * HALF + n * 16) = o; } }
    }
};
struct EpiSwiglu {
    static constexpr bool PERM = true, AFTER_DRAIN = false;
    bf16_t* A;
    __device__ __forceinline__ void operator()(const f32x4 (&acc)[2][2][4][2], const Unit& u, int wr, int wc, int fr, int fq) const {
        const int col0 = u.pn * HALF + wc * 32 + 8 * fq;
#pragma unroll
        for (int ai = 0; ai < 2; ++ai)
#pragma unroll
            for (int m = 0; m < 4; ++m) { const size_t row = (size_t)(u.pm * BM + wr * 64 + fr + ai * HALF + m * 16);
                f32x4 r[2];
#pragma unroll
                for (int n = 0; n < 2; ++n) { const f32x4 g = acc[ai][0][m][n], up = acc[ai][1][m][n];
#pragma unroll
                    for (int e = 0; e < 4; ++e) r[n][e] = g[e] * sigmoidf_(g[e]) * up[e]; }
                *(u32x4*)(A + row * DFF + col0) = pack8(r[0], r[1]); }
    }
};
}
namespace attn {
using bf16 = __hip_bfloat16;
constexpr int D = 128, NW = 8, QBLK = 32, KVBLK = 64;
constexpr float SCALE = 0.088388347648318440f;
constexpr float THR = 8.f;
constexpr int SDEPTH = 2;
constexpr int LDQ = 1024, LDK = 256, LDO = 1024;
constexpr size_t SHM_V = KVBLK * D * 2, SHM_K = KVBLK * D * 2, SHM_ATTN = 2 * SHM_V + 2 * SHM_K + NW * 64 * 4;

using bf16x8 = __attribute__((ext_vector_type(8))) short;
using s16x4  = __attribute__((ext_vector_type(4))) short;
using f32x16 = __attribute__((ext_vector_type(16))) float;
using f32x8  = __attribute__((ext_vector_type(8))) float;
using u32x4  = __attribute__((ext_vector_type(4))) unsigned;
using f32x2  = __attribute__((ext_vector_type(2))) float;
using f32x4  = __attribute__((ext_vector_type(4))) float;
#define KSWZ(row, colB) ((row) * 256 + ((colB) ^ (((row) & 7) << 4)))
#define SBAR() __builtin_amdgcn_sched_barrier(0)
__device__ __forceinline__ int crow(int r, int hi) { return (r & 3) + 8 * (r >> 2) + 4 * hi; }
__device__ __forceinline__ unsigned cvtpk(float lo, float hi) {
  unsigned r; asm volatile("v_cvt_pk_bf16_f32 %0, %1, %2" : "=v"(r) : "v"(lo), "v"(hi)); return r;
}
template <typename TIn> struct Stage;
template <> struct Stage<bf16>  { using T = bf16x8;
  __device__ static __forceinline__ T ld8(const bf16* p) { return *reinterpret_cast<const bf16x8*>(p); }
  __device__ static __forceinline__ bf16x8 tobf(T x) { return x; } };
__device__ __forceinline__ void partialSM(f32x16& p0, f32x16& p1, float& m_reg, float& mn, float& alpha) {
  constexpr float C = SCALE * 1.4426950408889634f;
  float pmax = p0[0]; for (int r = 1; r < 16; ++r) pmax = fmaxf(pmax, p0[r]); for (int r = 0; r < 16; ++r) pmax = fmaxf(pmax, p1[r]);
  { auto rr = __builtin_amdgcn_permlane32_swap(__float_as_uint(pmax), __float_as_uint(pmax), false, false);
    pmax = fmaxf(__uint_as_float(rr[0]), __uint_as_float(rr[1])); }
  if (__builtin_expect(__all(pmax - m_reg <= THR / SCALE), 1)) { mn = m_reg; alpha = 1.f; }
  else { mn = fmaxf(m_reg, pmax); alpha = __builtin_amdgcn_exp2f((m_reg - mn) * C); m_reg = mn; }
  float mnC = -mn * C;
  for (int r = 0; r < 16; ++r) p0[r] = fmaf(p0[r], C, mnC); for (int r = 0; r < 16; ++r) p1[r] = fmaf(p1[r], C, mnC);
  for (int r = 0; r < 16; ++r) p0[r] = __builtin_amdgcn_exp2f(p0[r]);
}
__device__ __forceinline__ void finishSM(f32x16& p0, f32x16& p1, float alpha, float& l_reg, bf16x8& pa0, bf16x8& pa1, bf16x8& pa2, bf16x8& pa3) {
  for (int r = 0; r < 16; ++r) p1[r] = __builtin_amdgcn_exp2f(p1[r]);
  float ps = 0; for (int r = 0; r < 16; ++r) ps += p0[r]; for (int r = 0; r < 16; ++r) ps += p1[r];
  { auto rr = __builtin_amdgcn_permlane32_swap(__float_as_uint(ps), __float_as_uint(ps), false, false);
    ps = __uint_as_float(rr[0]) + __uint_as_float(rr[1]); }
  l_reg = l_reg * alpha + ps;
#define PK4(P, BASE, OUT) do { unsigned a0 = cvtpk(P[BASE + 0], P[BASE + 1]), a1 = cvtpk(P[BASE + 2], P[BASE + 3]);   \
    unsigned b0 = cvtpk(P[BASE + 4], P[BASE + 5]), b1 = cvtpk(P[BASE + 6], P[BASE + 7]);                              \
    auto r0 = __builtin_amdgcn_permlane32_swap(a0, b0, false, false); auto r1 = __builtin_amdgcn_permlane32_swap(a1, b1, false, false); \
    u32x4 w = {r0[0], r1[0], r0[1], r1[1]}; OUT = *reinterpret_cast<bf16x8*>(&w); } while (0)
  PK4(p0, 0, pa0); PK4(p0, 8, pa1); PK4(p1, 0, pa2); PK4(p1, 8, pa3);
#undef PK4
}
__device__ __forceinline__ void qkt(f32x16& p0, f32x16& p1, const bf16* Ks, const bf16x8* qr, int r32, int hi) {
  p0 = f32x16{}; p1 = f32x16{};
  for (int d0 = 0; d0 < 8; ++d0) { int cb = (d0 * 16 + hi * 8) * 2;
    bf16x8 b0 = *reinterpret_cast<const bf16x8*>((const char*)Ks + KSWZ(r32, cb));
    bf16x8 b1 = *reinterpret_cast<const bf16x8*>((const char*)Ks + KSWZ(32 + r32, cb));
    p0 = __builtin_amdgcn_mfma_f32_32x32x16_bf16(b0, qr[d0], p0, 0, 0, 0);
    p1 = __builtin_amdgcn_mfma_f32_32x32x16_bf16(b1, qr[d0], p1, 0, 0, 0); }
}
__device__ __forceinline__ int v_st(int k, int c) { const int kk = (k & ~0xC) | ((k & 4) << 1) | ((k & 8) >> 1); return ((kk >> 3) * 4 + (c >> 5)) * 512 + ((kk & 7) * 32 + (c & 31)) * 2; }
__device__ __forceinline__ int v_rd_base(int lane) { return ((lane & 3) << 3) | (((lane >> 2) & 3) << 6) | (((lane >> 4) & 1) << 5) | (((lane >> 5) & 1) << 8); }
constexpr int v_rd_off(int d0, int ks, int half) { return d0 * 512 + ks * 4096 + half * 2048; }
template <int OFF> __device__ __forceinline__ s16x4 tr_read(int vb) {
  s16x4 r; asm volatile("ds_read_b64_tr_b16 %0, %1 offset:%2" : "=&v"(r) : "v"(vb), "i"(OFF) : "memory"); return r;
}
template <int D0> __device__ __forceinline__ void pv_one(f32x16& od, int vb, bf16x8 pa0, bf16x8 pa1, bf16x8 pa2, bf16x8 pa3) {
  const s16x4 l0 = tr_read<v_rd_off(D0, 0, 0)>(vb), h0 = tr_read<v_rd_off(D0, 0, 1)>(vb), l1 = tr_read<v_rd_off(D0, 1, 0)>(vb), h1 = tr_read<v_rd_off(D0, 1, 1)>(vb);
  const s16x4 l2 = tr_read<v_rd_off(D0, 2, 0)>(vb), h2 = tr_read<v_rd_off(D0, 2, 1)>(vb), l3 = tr_read<v_rd_off(D0, 3, 0)>(vb), h3 = tr_read<v_rd_off(D0, 3, 1)>(vb);
  asm volatile("s_waitcnt lgkmcnt(0)" ::: "memory"); SBAR();
#define PK(L, H) (bf16x8){L[0], L[1], L[2], L[3], H[0], H[1], H[2], H[3]}
  od = __builtin_amdgcn_mfma_f32_32x32x16_bf16(pa0, PK(l0, h0), od, 0, 0, 0);
  od = __builtin_amdgcn_mfma_f32_32x32x16_bf16(pa1, PK(l1, h1), od, 0, 0, 0);
  od = __builtin_amdgcn_mfma_f32_32x32x16_bf16(pa2, PK(l2, h2), od, 0, 0, 0);
  od = __builtin_amdgcn_mfma_f32_32x32x16_bf16(pa3, PK(l3, h3), od, 0, 0, 0);
#undef PK
}
__device__ __forceinline__ void pv_d0(f32x16* o, int vb, bf16x8 pa0, bf16x8 pa1, bf16x8 pa2, bf16x8 pa3) {
  pv_one<0>(o[0], vb, pa0, pa1, pa2, pa3); pv_one<1>(o[1], vb, pa0, pa1, pa2, pa3); pv_one<2>(o[2], vb, pa0, pa1, pa2, pa3); pv_one<3>(o[3], vb, pa0, pa1, pa2, pa3);
}

template <typename TQ>
__device__ __forceinline__ void attn_dense_body(const TQ* Qb, const bf16* __restrict__ Kh, const bf16* __restrict__ Vh,
                                                bf16* Ob, int seq, char* lds, const int tid_in, const float* qgain, const f32x2* rope_rows) {
  using St = Stage<bf16>; using SQ = Stage<TQ>;
  const int tid = tid_in, wid = tid >> 6, lane = tid & 63, r32 = lane & 31, hi = lane >> 5;
  bf16* V_lds = (bf16*)lds; bf16* K_lds = (bf16*)(lds + 2 * SHM_V);
  float* ws = (float*)(lds + 2 * SHM_V + 2 * SHM_K) + wid * 64; float* li_l = ws; float* al_l = ws + 32;
  float m_reg = -1e30f, l_reg = 0; f32x16 o[4] = {}; bf16x8 qr[8];
  const TQ* Qw = Qb + (long)(wid * QBLK + r32) * LDQ + hi * 8;
#pragma unroll
  for (int d0 = 0; d0 < 8; ++d0) qr[d0] = SQ::tobf(SQ::ld8(Qw + d0 * 16));
  {
    float ss = 0.f;
#pragma unroll
    for (int d0 = 0; d0 < 8; ++d0) { const u32x4 w = __builtin_bit_cast(u32x4, qr[d0]);
#pragma unroll
      for (int p = 0; p < 4; ++p) { const float x0 = __uint_as_float(w[p] << 16), x1 = __uint_as_float(w[p] & 0xffff0000u); ss += x0 * x0 + x1 * x1; } }
    { auto rr = __builtin_amdgcn_permlane32_swap(__float_as_uint(ss), __float_as_uint(ss), false, false); ss = __uint_as_float(rr[0]) + __uint_as_float(rr[1]); }
    const float rstd = __builtin_amdgcn_rsqf(ss * (1.f / 128.f) + 1e-6f);
    const float* gq = qgain + hi * 8; const f32x2* rp = rope_rows ? rope_rows + (long)(wid * QBLK + r32) * 64 + hi * 4 : nullptr;
#pragma unroll
    for (int d0 = 0; d0 < 8; ++d0) { u32x4 w = __builtin_bit_cast(u32x4, qr[d0]);
      const f32x4 ga = *(const f32x4*)(gq + d0 * 16), gb = *(const f32x4*)(gq + d0 * 16 + 4);
#pragma unroll
      for (int p = 0; p < 4; ++p) { float x0 = __uint_as_float(w[p] << 16) * rstd * (p < 2 ? ga[(2 * p) & 3] : gb[(2 * p) & 3]), x1 = __uint_as_float(w[p] & 0xffff0000u) * rstd * (p < 2 ? ga[(2 * p + 1) & 3] : gb[(2 * p + 1) & 3]);
        if (rp) { const f32x2 cs = rp[d0 * 8 + p]; const float y0 = x0 * cs.x - x1 * cs.y, y1 = x0 * cs.y + x1 * cs.x; x0 = y0; x1 = y1; }
        w[p] = cvtpk(x0, x1); }
      qr[d0] = __builtin_bit_cast(bf16x8, w); } }
  const int sr = tid >> 4, sc = (tid & 15) * 8, vst0 = v_st(sr, sc), vst1 = v_st(32 + sr, sc);
  const int vb0 = (int)(uintptr_t)V_lds + v_rd_base(lane);
  struct { typename St::T vs0, vs1, ks0, ks1; } sr_[SDEPTH];
#define SLOAD(i, k0) do { sr_[i].vs0 = St::ld8(&Vh[(long)((k0) + sr) * LDK + sc]); sr_[i].vs1 = St::ld8(&Vh[(long)((k0) + 32 + sr) * LDK + sc]); \
    sr_[i].ks0 = St::ld8(&Kh[(long)((k0) + sr) * LDK + sc]); sr_[i].ks1 = St::ld8(&Kh[(long)((k0) + 32 + sr) * LDK + sc]); } while (0)
#define SWRITE(b, i) do { *(bf16x8*)((char*)V_lds + (b) * SHM_V + vst0) = St::tobf(sr_[i].vs0);          \
    *(bf16x8*)((char*)V_lds + (b) * SHM_V + vst1) = St::tobf(sr_[i].vs1); int kc = sc * 2;               \
    *(bf16x8*)((char*)K_lds + (b) * SHM_K + KSWZ(sr, kc)) = St::tobf(sr_[i].ks0);                       \
    *(bf16x8*)((char*)K_lds + (b) * SHM_K + KSWZ(32 + sr, kc)) = St::tobf(sr_[i].ks1); } while (0)
#define SWAIT() do { if constexpr (SDEPTH == 2) asm volatile("s_waitcnt vmcnt(4)" ::: "memory"); else asm volatile("s_waitcnt vmcnt(0)" ::: "memory"); } while (0)
#define RESC(a) do { if (__any((a) < 1.f)) { if (hi == 0) al_l[r32] = (a); asm volatile("s_waitcnt lgkmcnt(0)" ::: "memory"); \
    for (int d = 0; d < 4; ++d) for (int r = 0; r < 16; ++r) o[d][r] *= al_l[crow(r, hi)]; } } while (0)
  f32x16 pA0, pA1, pB0, pB1; float mnA, mnB, alA, alB; bf16x8 pa0, pa1, pa2, pa3; const int NT = seq / KVBLK;
  constexpr int SE = 0, SO = SDEPTH - 1;
  SLOAD(SE, 0); asm volatile("s_waitcnt vmcnt(0)" ::: "memory"); SWRITE(0, SE); __syncthreads();
  qkt(pA0, pA1, K_lds, qr, r32, hi); partialSM(pA0, pA1, m_reg, mnA, alA);
  SLOAD(SO, KVBLK); if constexpr (SDEPTH == 2) { if (2 < NT) SLOAD(SE, 2 * KVBLK); }
  SWAIT(); SWRITE(1, SO); __syncthreads();
  for (int j = 1; j + 1 < NT; j += 2) {
    SBAR(); qkt(pB0, pB1, (bf16*)((char*)K_lds + SHM_K), qr, r32, hi);
    finishSM(pA0, pA1, alA, l_reg, pa0, pa1, pa2, pa3); SBAR();
    SLOAD(SO, (j + SDEPTH) * KVBLK); SBAR();
    pv_d0(o, vb0, pa0, pa1, pa2, pa3); partialSM(pB0, pB1, m_reg, mnB, alB);
    __syncthreads(); SWAIT(); SWRITE(0, SE);
    RESC(alB); __syncthreads();
    SBAR(); qkt(pA0, pA1, K_lds, qr, r32, hi);
    finishSM(pB0, pB1, alB, l_reg, pa0, pa1, pa2, pa3); SBAR();
    if (SDEPTH == 1 || j + 3 < NT) SLOAD(SE, (j + 1 + SDEPTH) * KVBLK); SBAR();
    pv_d0(o, vb0 + (int)SHM_V, pa0, pa1, pa2, pa3); partialSM(pA0, pA1, m_reg, mnA, alA);
    __syncthreads(); SWAIT(); SWRITE(1, SO);
    RESC(alA); __syncthreads();
  }
  SBAR(); qkt(pB0, pB1, (bf16*)((char*)K_lds + SHM_K), qr, r32, hi);
  finishSM(pA0, pA1, alA, l_reg, pa0, pa1, pa2, pa3); SBAR();
  pv_d0(o, vb0, pa0, pa1, pa2, pa3); partialSM(pB0, pB1, m_reg, mnB, alB);
  __syncthreads(); RESC(alB);
  finishSM(pB0, pB1, alB, l_reg, pa0, pa1, pa2, pa3); SBAR();
  pv_d0(o, vb0 + (int)SHM_V, pa0, pa1, pa2, pa3);
  if (hi == 0) li_l[r32] = l_reg; asm volatile("s_waitcnt lgkmcnt(0)" ::: "memory");
  float rli[16];
#pragma unroll
  for (int r = 0; r < 16; ++r) rli[r] = __builtin_amdgcn_rcpf(li_l[crow(r, hi)]);
  unsigned short* Ow = (unsigned short*)Ob + (long)(wid * QBLK) * LDO;
#pragma unroll
  for (int r = 0; r < 16; ++r) { int orow = crow(r, hi);
    for (int d0 = 0; d0 < 4; ++d0) Ow[(long)orow * LDO + d0 * 32 + r32] = (unsigned short)(cvtpk(o[d0][r] * rli[r], 0.f) & 0xffffu); }
#undef SLOAD
#undef SWRITE
#undef SWAIT
#undef RESC
}

}
#define XB_TMO      128
#define XB_XCNT(j)  (256  + 64 * (j))
#define XB_XSUB(j)  (1280 + 64 * (j))
#define XB_XGEN(j)  (2304 + 64 * (j))
#define XB_TOP      3328
#define XB_TOPGEN   3392
#define XCD_BAR_WORDS 3456
#define XB_SPIN_CAP (1u << 18)

__device__ __forceinline__ unsigned xb_ld(unsigned* p)              { return __hip_atomic_load(p, __ATOMIC_RELAXED, __HIP_MEMORY_SCOPE_AGENT); }
__device__ __forceinline__ unsigned xb_add(unsigned* p, unsigned v) { return __hip_atomic_fetch_add(p, v, __ATOMIC_RELAXED, __HIP_MEMORY_SCOPE_AGENT); }
__device__ __forceinline__ unsigned xb_xcc_id() { return (unsigned)__builtin_amdgcn_s_getreg((3 << 11) | 20) & 0xFu; }
#define XB_SPIN(cond, bar) do { unsigned _sp = 0; while (cond) { __builtin_amdgcn_s_sleep(1); \
    if ((++_sp & 255u) == 0u) { if (xb_ld(&(bar)[XB_TMO])) break; if (_sp > XB_SPIN_CAP) { atomicAdd(&(bar)[XB_TMO], 1u); break; } } } } while (0)

struct XcdBarrier {
    int tid; unsigned* bar; unsigned x;
    volatile LAS unsigned* st;
};

__device__ __forceinline__ XcdBarrier xcd_barrier_post(unsigned* bar, volatile LAS unsigned* st, int tid) {
    XcdBarrier b; b.tid = tid; b.bar = bar; b.x = xb_xcc_id(); b.st = st;
    if (b.tid == 0) (void)xb_add(&bar[XB_XCNT(b.x)], 1u);
    return b;
}
__device__ __forceinline__ void xcd_barrier_complete(unsigned* bar, unsigned x, unsigned& nloc, unsigned& nx) {
    const unsigned G = gridDim.x * gridDim.y * gridDim.z;
    unsigned sum, cnt, mine, sp = 0u;
    for (;;) {
        sum = 0u; cnt = 0u; mine = 0u;
#pragma unroll
        for (unsigned j = 0; j < 16; ++j) { const unsigned c = xb_ld(&bar[XB_XCNT(j)]); sum += c; cnt += (c > 0u) ? 1u : 0u; mine = (j == x) ? c : mine; }
        if (sum == G) break;
        __builtin_amdgcn_s_sleep(1);
        if ((++sp & 255u) == 0u) { if (xb_ld(&bar[XB_TMO])) break; if (sp > XB_SPIN_CAP) { atomicAdd(&bar[XB_TMO], 1u); break; } }
    }
    nloc = mine > 0u ? mine : 1u; nx = cnt > 0u ? cnt : 1u;
}

__device__ __forceinline__ void xcd_barrier(const XcdBarrier& b) {
    asm volatile("s_waitcnt vmcnt(0)" ::: "memory");
    __syncthreads();
    if (b.tid == 0) {
        unsigned* bar = b.bar;
        __builtin_amdgcn_s_waitcnt(0);
        unsigned nloc = b.st[0], nx = b.st[1];
        const unsigned old = xb_add(&bar[XB_XSUB(b.x)], 1u);
        const unsigned gen = old / nloc;
        if (old + 1u == (gen + 1u) * nloc) {
            __builtin_amdgcn_fence(__ATOMIC_RELEASE, "agent");
            asm volatile("s_waitcnt vmcnt(0)" ::: "memory");
            const unsigned og = xb_add(&bar[XB_TOP], 1u);
            const unsigned tg = og / nx;
            if (og + 1u == (tg + 1u) * nx) xb_add(&bar[XB_TOPGEN], 1u);
            else XB_SPIN(xb_ld(&bar[XB_TOPGEN]) == tg, bar);
            __builtin_amdgcn_fence(__ATOMIC_ACQUIRE, "agent");
            xb_add(&bar[XB_XGEN(b.x)], 1u);
            asm volatile("s_waitcnt vmcnt(0)" ::: "memory");
        } else {
            XB_SPIN(xb_ld(&bar[XB_XGEN(b.x)]) == gen, bar);
            __builtin_amdgcn_fence(__ATOMIC_ACQUIRE, "agent");
            asm volatile("s_waitcnt vmcnt(0)" ::: "memory");
        }
    }
    __syncthreads();
}

#define LDS_WAIT() asm volatile("s_waitcnt lgkmcnt(0)" ::: "memory")
__device__ __forceinline__ void transpose_item(const float* W, int K, int N, bf16_t* WT, int k0, int n0, int drow0, LAS float* scr, int lane) {
#pragma unroll
    for (int i = 0; i < 32; ++i) { const int kk = 2 * i + (lane >> 5); scr[kk * 33 + (lane & 31)] = W[(size_t)(k0 + kk) * N + n0 + (lane & 31)]; }
    LDS_WAIT(); asm volatile("" ::: "memory");
    const int c = lane & 7;
#pragma unroll
    for (int j = 0; j < 4; ++j) { const int n = (lane >> 3) + 8 * j; const LAS float* s = scr + (8 * c) * 33 + n;
        u32x4 o; o.x = pk2(s[0 * 33], s[1 * 33]); o.y = pk2(s[2 * 33], s[3 * 33]); o.z = pk2(s[4 * 33], s[5 * 33]); o.w = pk2(s[6 * 33], s[7 * 33]);
        *(u32x4*)(WT + (size_t)(drow0 + n) * K + k0 + 8 * c) = o; }
    LDS_WAIT(); asm volatile("" ::: "memory");
}
__device__ __forceinline__ void phase_weights(const Params& p, LAS unsigned char* lds, int gw, int NGW, int wave, int lane) {
    LAS float* scr = (LAS float*)(lds + wave * 16384);
    constexpr int I0 = 16 * 160, I1 = 16 * 32, I2 = 8 * 32, I3 = 16 * 32, I4 = 16 * 176, I5 = 44 * 32, IL = I0 + I1 + I2 + I3 + I4 + I5;
    for (int it = gw; it < 2 * IL; it += NGW) {
        const int l = it / IL; int r = it % IL; unsigned char* wb = p.ws + WS_W + (size_t)l * WL_STRIDE;
        if (r < I0) { const int kb = r / 160, nb = r % 160; transpose_item(p.w_in + (size_t)l * DM * PROJ, DM, PROJ, (bf16_t*)(wb + WL_IN), kb * 64, nb * 32, nb * 32, scr, lane); continue; } r -= I0;
        if (r < I1) { const int kb = r / 32, nb = r % 32; transpose_item(p.w_oa + (size_t)l * DM * DM, DM, DM, (bf16_t*)(wb + WL_OA), kb * 64, nb * 32, nb * 32, scr, lane); continue; } r -= I1;
        if (r < I2) { const int kb = r / 32, nb = r % 32; transpose_item(p.w_oh + (size_t)l * HYW * DM, HYW, DM, (bf16_t*)(wb + WL_OH), kb * 64, nb * 32, nb * 32, scr, lane); continue; } r -= I2;
        if (r < I3) { const int kb = r / 32, nb = r % 32; transpose_item(p.w_out + (size_t)l * DM * DM, DM, DM, (bf16_t*)(wb + WL_OUT), kb * 64, nb * 32, nb * 32, scr, lane); continue; } r -= I3;
        if (r < I4) { const int kb = r / 176, nb = r % 176; const int n0 = nb * 32; const int nn = n0 < DFF ? n0 : n0 - DFF; const int drow = 256 * (nn / 128) + (nn % 128) + (n0 < DFF ? 0 : 128);
            transpose_item(p.w_gu + (size_t)l * DM * 2 * DFF, DM, 2 * DFF, (bf16_t*)(wb + WL_GU), kb * 64, n0, drow, scr, lane); continue; } r -= I4;
        { const int kb = r / 32, nb = r % 32; transpose_item(p.w_dn + (size_t)l * DFF * DM, DFF, DM, (bf16_t*)(wb + WL_DN), kb * 64, nb * 32, nb * 32, scr, lane); }
    }
}
__device__ __forceinline__ void mod_unit(const Params& p, int unit, LAS unsigned char* lds, int tid) {
    LAS float* s = (LAS float*)lds; LAS float* red = (LAS float*)(lds + 40960);
    const int l = unit / 96, n0 = (unit % 96) * 64, col = tid & 63, ks = tid >> 6;
    for (int e = tid; e < 9 * 1024; e += 512) { const float v = e < 8192 ? p.c[e] : p.c_ctx[e - 8192]; s[e] = v / (1.f + __expf(-v)); }
    __syncthreads();
    const float* W = p.w_mod + (size_t)l * DM * NMODV + n0 + col;
    float acc[9];
#pragma unroll
    for (int j = 0; j < 9; ++j) acc[j] = 0.f;
#pragma unroll 2
    for (int k = ks * 128; k < ks * 128 + 128; k += 4) {
        const float w0 = W[(size_t)k * NMODV], w1 = W[(size_t)(k + 1) * NMODV], w2 = W[(size_t)(k + 2) * NMODV], w3 = W[(size_t)(k + 3) * NMODV];
#pragma unroll
        for (int j = 0; j < 9; ++j) { const f32x4 sv = *(const LAS f32x4*)(s + j * 1024 + k); acc[j] += sv[0] * w0 + sv[1] * w1 + sv[2] * w2 + sv[3] * w3; }
    }
#pragma unroll
    for (int j = 0; j < 9; ++j) red[(ks * 9 + j) * 64 + col] = acc[j];
    __syncthreads();
    for (int e = tid; e < 9 * 64; e += 512) { const int j = e >> 6, c = e & 63; float sum = 0.f;
#pragma unroll
        for (int q = 0; q < 8; ++q) sum += red[(q * 9 + j) * 64 + c];
        ((float*)(p.ws + WS_MOD))[((size_t)l * 9 + j) * NMODV + n0 + c] = sum + p.b_mod[(size_t)l * NMODV + n0 + c]; }
    __syncthreads();
}
__device__ __forceinline__ void shiftw_unit(const float* sbase, const float* W, int ldw, int n0, float* out, int ldo, LAS unsigned char* lds, int tid) {
    LAS float* s = (LAS float*)lds; LAS float* red = (LAS float*)(lds + 40960);
    const int col = tid & 63, ks = tid >> 6;
    for (int e = tid; e < 9 * 1024; e += 512) s[e] = sbase[(size_t)(e >> 10) * NMODV + (e & 1023)];
    __syncthreads();
    const float* Wc = W + n0 + col;
    float acc[9];
#pragma unroll
    for (int j = 0; j < 9; ++j) acc[j] = 0.f;
#pragma unroll 2
    for (int k = ks * 128; k < ks * 128 + 128; k += 4) {
        const float w0 = Wc[(size_t)k * ldw], w1 = Wc[(size_t)(k + 1) * ldw], w2 = Wc[(size_t)(k + 2) * ldw], w3 = Wc[(size_t)(k + 3) * ldw];
#pragma unroll
        for (int j = 0; j < 9; ++j) { const f32x4 sv = *(const LAS f32x4*)(s + j * 1024 + k); acc[j] += sv[0] * w0 + sv[1] * w1 + sv[2] * w2 + sv[3] * w3; }
    }
#pragma unroll
    for (int j = 0; j < 9; ++j) red[(ks * 9 + j) * 64 + col] = acc[j];
    __syncthreads();
    for (int e = tid; e < 9 * 64; e += 512) { const int j = e >> 6, c = e & 63; float sum = 0.f;
#pragma unroll
        for (int qq = 0; qq < 8; ++qq) sum += red[(qq * 9 + j) * 64 + c];
        out[(size_t)j * ldo + n0 + c] = sum; }
    __syncthreads();
}
constexpr int FW_OFF = 32768 / 4, FW2_O = 2112, FW3_O = 6208, FB1_O = 10304, FB2_O = 10368, FB3_O = 10432, FRQ_O = 10496;
__device__ __forceinline__ void filter_stage_weights(const Params& p, int l, LAS unsigned char* lds, int tid) {
    LAS float* W = (LAS float*)lds + FW_OFF;
    for (int e = tid; e < 2112; e += 512) W[e] = p.fw1[(size_t)l * 2112 + e];
    for (int e = tid; e < 4096; e += 512) { W[FW2_O + e] = p.fw2[(size_t)l * 4096 + e]; W[FW3_O + e] = p.fw3[(size_t)l * 4096 + e]; }
    if (tid < 64) { W[FB1_O + tid] = p.fb1[l * 64 + tid]; W[FB2_O + tid] = p.fb2[l * 64 + tid]; W[FB3_O + tid] = p.fb3[l * 64 + tid]; }
    if (tid < 192) W[FRQ_O + tid] = p.freq[(size_t)l * 192 + tid];
    __syncthreads();
}
__device__ __forceinline__ void filter_unit(const Params& p, int l, int L, int t0, float* dst, bool transposed, LAS unsigned char* lds, int tid) {
    LAS float* z = (LAS float*)lds; LAS float* h1 = z + 1024; LAS float* h2 = h1 + 1024; LAS float* h3t = h2 + 1024;
    const LAS float* W = (const LAS float*)lds + FW_OFF;
    const float wstep = (float)(2.0 * 3.14159265358979323846 / (double)L), invL1 = 1.f / (float)(L - 1);
    for (int e = tid; e < 16 * 33; e += 512) { const int tl = e / 33, i = e % 33; const float tf = (float)(t0 + tl); float val;
        if (i == 0) val = tf * invL1;
        else { const int j = (i - 1) & 15; const float f = 1e-4f + (float)j * ((15.f - 1e-4f) / 15.f); const float a = f * (wstep * tf); val = (i <= 16) ? cosf(a) : -sinf(a); }
        z[tl * 36 + i] = val; }
    __syncthreads();
    for (int e = tid; e < 1024; e += 512) { const int tl = e >> 6, m = e & 63; float sacc = W[FB1_O + m];
#pragma unroll 3
        for (int i = 0; i < 33; ++i) sacc += z[tl * 36 + i] * W[i * 64 + m];
        h1[e] = sinf(W[FRQ_O + m] * sacc); }
    __syncthreads();
    for (int e = tid; e < 1024; e += 512) { const int tl = e >> 6, m = e & 63; float sacc = W[FB2_O + m];
#pragma unroll 4
        for (int i = 0; i < 64; ++i) sacc += h1[tl * 64 + i] * W[FW2_O + i * 64 + m];
        h2[e] = sinf(W[FRQ_O + 64 + m] * sacc); }
    __syncthreads();
    for (int e = tid; e < 1024; e += 512) { const int tl = e >> 6, m = e & 63; float sacc = W[FB3_O + m];
#pragma unroll 4
        for (int i = 0; i < 64; ++i) sacc += h2[tl * 64 + i] * W[FW3_O + i * 64 + m];
        h3t[m * 16 + tl] = sinf(W[FRQ_O + 128 + m] * sacc); }
    __syncthreads();
    const float mind = -3.0701134573253945f, maxd = -15.350567286626972f;
    { const float* w4 = p.fw4 + (size_t)l * 64 * 1024 + tid; float acc0[16], acc1[16];
#pragma unroll
      for (int tl = 0; tl < 16; ++tl) { acc0[tl] = 0.f; acc1[tl] = 0.f; }
#pragma unroll 4
      for (int m = 0; m < 64; ++m) { const float wa = w4[(size_t)m * 1024], wb = w4[(size_t)m * 1024 + 512];
          const f32x4 h0 = *(const LAS f32x4*)(h3t + m * 16), hq1 = *(const LAS f32x4*)(h3t + m * 16 + 4), hq2 = *(const LAS f32x4*)(h3t + m * 16 + 8), hq3 = *(const LAS f32x4*)(h3t + m * 16 + 12);
#pragma unroll
          for (int k = 0; k < 4; ++k) { acc0[k] += h0[k] * wa; acc1[k] += h0[k] * wb; acc0[4 + k] += hq1[k] * wa; acc1[4 + k] += hq1[k] * wb;
                                        acc0[8 + k] += hq2[k] * wa; acc1[8 + k] += hq2[k] * wb; acc0[12 + k] += hq3[k] * wa; acc1[12 + k] += hq3[k] * wb; } }
      const float delta = fabsf(mind + (float)tid * ((maxd - mind) / 511.f));
#pragma unroll
      for (int tl = 0; tl < 16; ++tl) { const float dc = expf(-((float)(t0 + tl) * invL1) * delta); acc0[tl] *= dc; acc1[tl] *= dc; }
      if (transposed) { float* d0 = dst + (size_t)tid * SEQ + t0; float* d1 = dst + (size_t)(tid + 512) * SEQ + t0;
#pragma unroll
          for (int q = 0; q < 4; ++q) { *(f32x4*)(d0 + 4 * q) = (f32x4){acc0[4 * q], acc0[4 * q + 1], acc0[4 * q + 2], acc0[4 * q + 3]}; *(f32x4*)(d1 + 4 * q) = (f32x4){acc1[4 * q], acc1[4 * q + 1], acc1[4 * q + 2], acc1[4 * q + 3]}; } }
      else {
#pragma unroll
          for (int tl = 0; tl < 16; ++tl) { dst[(size_t)(t0 + tl) * 1024 + tid] = acc0[tl]; dst[(size_t)(t0 + tl) * 1024 + tid + 512] = acc1[tl]; } }
    }
    __syncthreads();
}
__device__ __forceinline__ f32x2 cmul(f32x2 a, f32x2 b) { return (f32x2){a.x * b.x - a.y * b.y, a.x * b.y + a.y * b.x}; }
__device__ __forceinline__ int PADI(int i) { return i + 4 * (i >> 6); }
__device__ __forceinline__ f32x2 tw_get(const LAS f32x2* T, int k) { const f32x2 h = T[k & 2047]; const float c = 0.70710678118654752f; const f32x2 r = {(h.x + h.y) * c, (h.y - h.x) * c}; return (k & 2048) ? r : h; }
__device__ __forceinline__ void bfly_fwd(f32x2& a, f32x2& b, f32x2& c, f32x2& d, f32x2 w1) {
    const f32x2 w2 = cmul(w1, w1), w3 = cmul(w2, w1);
    const f32x2 s0 = a + c, s1 = a - c, s2 = b + d, s3 = b - d;
    a = s0 + s2; b = cmul((f32x2){s1.x + s3.y, s1.y - s3.x}, w1); c = cmul(s0 - s2, w2); d = cmul((f32x2){s1.x - s3.y, s1.y + s3.x}, w3);
}
__device__ __forceinline__ void bfly_inv(f32x2& a, f32x2& b, f32x2& c, f32x2& d, f32x2 w1c) {
    const f32x2 w2 = cmul(w1c, w1c), w3 = cmul(w2, w1c);
    b = cmul(b, w1c); c = cmul(c, w2); d = cmul(d, w3);
    const f32x2 s0 = a + c, s1 = a - c, s2 = b + d, s3 = b - d;
    a = s0 + s2; b = (f32x2){s1.x - s3.y, s1.y + s3.x}; c = s0 - s2; d = (f32x2){s1.x + s3.y, s1.y - s3.x};
}
__device__ __forceinline__ void bfly_fwd1(f32x2& a, f32x2& b, f32x2& c, f32x2& d) {
    const f32x2 s0 = a + c, s1 = a - c, s2 = b + d, s3 = b - d;
    a = s0 + s2; b = (f32x2){s1.x + s3.y, s1.y - s3.x}; c = s0 - s2; d = (f32x2){s1.x - s3.y, s1.y + s3.x};
}
__device__ __forceinline__ void bfly_inv1(f32x2& a, f32x2& b, f32x2& c, f32x2& d) {
    const f32x2 s0 = a + c, s1 = a - c, s2 = b + d, s3 = b - d;
    a = s0 + s2; b = (f32x2){s1.x - s3.y, s1.y + s3.x}; c = s0 - s2; d = (f32x2){s1.x + s3.y, s1.y - s3.x};
}
template <int PS> __device__ __forceinline__ void fwd2_regs(f32x2 (&e)[4][4], const LAS f32x2* tw, int j) {
    constexpr int q16 = (NFFT >> (2 * PS)) / 16;
#pragma unroll
    for (int k2 = 0; k2 < 4; ++k2) bfly_fwd(e[0][k2], e[1][k2], e[2][k2], e[3][k2], tw_get(tw, (j + k2 * q16) << (2 * PS)));
    const f32x2 w1 = tw_get(tw, j << (2 * PS + 2));
#pragma unroll
    for (int k1 = 0; k1 < 4; ++k1) bfly_fwd(e[k1][0], e[k1][1], e[k1][2], e[k1][3], w1);
}
template <int PS> __device__ __forceinline__ void inv2_regs(f32x2 (&e)[4][4], const LAS f32x2* tw, int j) {
    constexpr int q16 = (NFFT >> (2 * PS)) / 16;
    f32x2 w1 = tw_get(tw, j << (2 * PS + 2)); w1.y = -w1.y;
#pragma unroll
    for (int k1 = 0; k1 < 4; ++k1) bfly_inv(e[k1][0], e[k1][1], e[k1][2], e[k1][3], w1);
#pragma unroll
    for (int k2 = 0; k2 < 4; ++k2) { f32x2 w = tw_get(tw, (j + k2 * q16) << (2 * PS)); w.y = -w.y; bfly_inv(e[0][k2], e[1][k2], e[2][k2], e[3][k2], w); }
}
template <int PS, bool INV> __device__ __forceinline__ void fft_pass2_lds(LAS f32x2* X, const LAS f32x2* tw, int tid) {
    constexpr int lq = 10 - 2 * PS;
#pragma unroll
    for (int w = tid; w < 1024; w += 512) {
        const int j = w & ((1 << lq) - 1), base = ((w >> lq) << (lq + 4)) + j;
        f32x2 e[4][4];
#pragma unroll
        for (int k = 0; k < 16; ++k) e[k >> 2][k & 3] = X[PADI(base + (k << lq))];
        if (INV) inv2_regs<PS>(e, tw, j); else fwd2_regs<PS>(e, tw, j);
#pragma unroll
        for (int k = 0; k < 16; ++k) X[PADI(base + (k << lq))] = e[k >> 2][k & 3];
    }
    __syncthreads();
}
__device__ __forceinline__ void kf_unit(const float* filtT, f32x2* KF, int c, LAS unsigned char* lds, int tid) {
    const LAS f32x2* tw = (const LAS f32x2*)(lds + LDS_TW_OFF);
    LAS f32x2* X = (LAS f32x2*)lds;
    const float* hf = filtT + (size_t)c * SEQ; const float* hb = filtT + (size_t)(HYW + c) * SEQ;
    for (int n = tid; n < SEQ; n += 512) { X[PADI(n)] = (f32x2){hf[n], 0.f}; X[PADI(SEQ + n)] = (f32x2){n == 0 ? 0.f : hb[SEQ - n], 0.f}; }
    __syncthreads();
    fft_pass2_lds<0, false>(X, tw, tid); fft_pass2_lds<2, false>(X, tw, tid); fft_pass2_lds<4, false>(X, tw, tid);
    f32x2* o = KF + (size_t)c * NFFT;
    for (int w = tid; w < 4096; w += 512) { const int p0 = PADI(4 * w); f32x2 a = X[p0], b = X[p0 + 1], cc = X[p0 + 2], d = X[p0 + 3];
        bfly_fwd1(a, b, cc, d); const float sc = 1.f / (float)NFFT;
        *(f32x4*)(o + 4 * w) = (f32x4){a.x * sc, a.y * sc, b.x * sc, b.y * sc}; *(f32x4*)(o + 4 * w + 2) = (f32x4){cc.x * sc, cc.y * sc, d.x * sc, d.y * sc}; }
    __syncthreads();
}
__device__ __forceinline__ void fftconv_units(bf16_t* VT, const f32x2* KF, int nunits, int bid, int G, LAS unsigned char* lds, int tid) {
    LAS f32x2* X = (LAS f32x2*)lds; const LAS f32x2* tw = (const LAS f32x2*)(lds + LDS_TW_OFF);
    const int w2 = 2 * tid;
    unsigned pre0[8], pre1[8];
    if (bid < nunits) { const bf16_t* s0 = VT + ((size_t)(bid >> 2) * NB + 2 * (bid & 3)) * SEQ;
#pragma unroll
        for (int k = 0; k < 8; ++k) { pre0[k] = *(const unsigned*)(s0 + w2 + (k << 10)); pre1[k] = *(const unsigned*)(s0 + SEQ + w2 + (k << 10)); } }
    for (int u = bid; u < nunits; u += G) {
        const int c = u >> 2, pair = u & 3;
        bf16_t* s0 = VT + ((size_t)c * NB + 2 * pair) * SEQ; bf16_t* s1 = s0 + SEQ;
        { f32x2 ea[4][4], eb[4][4];
#pragma unroll
          for (int k = 0; k < 8; ++k) { ea[k >> 2][k & 3] = (f32x2){bflo(pre0[k]), bflo(pre1[k])}; eb[k >> 2][k & 3] = (f32x2){bfhi(pre0[k]), bfhi(pre1[k])}; }
#pragma unroll
          for (int k = 8; k < 16; ++k) { ea[k >> 2][k & 3] = (f32x2){0.f, 0.f}; eb[k >> 2][k & 3] = (f32x2){0.f, 0.f}; }
          fwd2_regs<0>(ea, tw, w2); fwd2_regs<0>(eb, tw, w2 + 1);
#pragma unroll
          for (int k = 0; k < 16; ++k) { const int pi = PADI(w2 + (k << 10)); *(LAS f32x4*)(X + pi) = (f32x4){ea[k >> 2][k & 3].x, ea[k >> 2][k & 3].y, eb[k >> 2][k & 3].x, eb[k >> 2][k & 3].y}; } }
        __syncthreads();
        fft_pass2_lds<2, false>(X, tw, tid); fft_pass2_lds<4, false>(X, tw, tid);
        const f32x2* kf = KF + (size_t)c * NFFT;
#pragma unroll 2
        for (int w = tid; w < 4096; w += 512) { const int p0 = PADI(4 * w); f32x2 a = X[p0], b = X[p0 + 1], cc = X[p0 + 2], d = X[p0 + 3];
            const f32x4 k01 = *(const f32x4*)(kf + 4 * w), k23 = *(const f32x4*)(kf + 4 * w + 2);
            bfly_fwd1(a, b, cc, d);
            a = cmul(a, (f32x2){k01[0], k01[1]}); b = cmul(b, (f32x2){k01[2], k01[3]}); cc = cmul(cc, (f32x2){k23[0], k23[1]}); d = cmul(d, (f32x2){k23[2], k23[3]});
            bfly_inv1(a, b, cc, d);
            X[p0] = a; X[p0 + 1] = b; X[p0 + 2] = cc; X[p0 + 3] = d; }
        __syncthreads();
        if (u + G < nunits) { const int un = u + G; const bf16_t* n0 = VT + ((size_t)(un >> 2) * NB + 2 * (un & 3)) * SEQ;
#pragma unroll
            for (int k = 0; k < 8; ++k) { pre0[k] = *(const unsigned*)(n0 + w2 + (k << 10)); pre1[k] = *(const unsigned*)(n0 + SEQ + w2 + (k << 10)); } }
        fft_pass2_lds<4, true>(X, tw, tid); fft_pass2_lds<2, true>(X, tw, tid);
        { f32x2 ea[4][4], eb[4][4];
#pragma unroll
          for (int k = 0; k < 16; ++k) { const f32x4 v = *(const LAS f32x4*)(X + PADI(w2 + (k << 10))); ea[k >> 2][k & 3] = (f32x2){v[0], v[1]}; eb[k >> 2][k & 3] = (f32x2){v[2], v[3]}; }
          inv2_regs<0>(ea, tw, w2); inv2_regs<0>(eb, tw, w2 + 1);
#pragma unroll
          for (int k = 0; k < 8; ++k) { *(unsigned*)(s0 + w2 + (k << 10)) = pk2(ea[k >> 2][k & 3].x, eb[k >> 2][k & 3].x); *(unsigned*)(s1 + w2 + (k << 10)) = pk2(ea[k >> 2][k & 3].y, eb[k >> 2][k & 3].y); } }
        __syncthreads();
    }
}
struct SC8 { float v[8]; };
constexpr int LDS_CW_OFF = 98304;
__device__ __forceinline__ void stage_conv_weights(const float* cw, const float* cb, LAS unsigned char* lds, int tid) {
    LAS float* d = (LAS float*)(lds + LDS_CW_OFF);
    for (int e = tid; e < 3 * HYP; e += 512) d[e] = cw[e];
    for (int e = tid; e < HYP; e += 512) d[3 * HYP + e] = cb[e];
    __syncthreads();
}
__device__ __forceinline__ SC8 short_conv8(const bf16_t* hy0, int t, int len, int col, const LAS float* cwl) {
    const u32x4 z4 = {0u, 0u, 0u, 0u};
    const u32x4 um = t > 0 ? *(const u32x4*)(hy0 + (size_t)(t - 1) * HYP + col) : z4;
    const u32x4 u0 = *(const u32x4*)(hy0 + (size_t)t * HYP + col);
    const u32x4 up = t + 1 < len ? *(const u32x4*)(hy0 + (size_t)(t + 1) * HYP + col) : z4;
    const f32x4 w0a = *(const LAS f32x4*)(cwl + col), w0b = *(const LAS f32x4*)(cwl + col + 4), w1a = *(const LAS f32x4*)(cwl + HYP + col), w1b = *(const LAS f32x4*)(cwl + HYP + col + 4),
                w2a = *(const LAS f32x4*)(cwl + 2 * HYP + col), w2b = *(const LAS f32x4*)(cwl + 2 * HYP + col + 4), ba = *(const LAS f32x4*)(cwl + 3 * HYP + col), bb = *(const LAS f32x4*)(cwl + 3 * HYP + col + 4);
    SC8 r;
#pragma unroll
    for (int e = 0; e < 4; ++e) {
        const unsigned a = um[e], b = u0[e], c = up[e]; const int k = 2 * e;
        const float w0l = k < 4 ? w0a[k & 3] : w0b[k & 3], w1l = k < 4 ? w1a[k & 3] : w1b[k & 3], w2l = k < 4 ? w2a[k & 3] : w2b[k & 3], bl = k < 4 ? ba[k & 3] : bb[k & 3];
        const float w0h = k < 4 ? w0a[(k + 1) & 3] : w0b[(k + 1) & 3], w1h = k < 4 ? w1a[(k + 1) & 3] : w1b[(k + 1) & 3], w2h = k < 4 ? w2a[(k + 1) & 3] : w2b[(k + 1) & 3], bh = k < 4 ? ba[(k + 1) & 3] : bb[(k + 1) & 3];
        r.v[k] = bflo(a) * w0l + bflo(b) * w1l + bflo(c) * w2l + bl;
        r.v[k + 1] = bfhi(a) * w0h + bfhi(b) * w1h + bfhi(c) * w2h + bh;
    }
    return r;
}
__device__ __forceinline__ void hy_pre_unit(const bf16_t* HY, bf16_t* VT, int unit, LAS unsigned char* lds, int tid) {
    const LAS float* cwl = (const LAS float*)(lds + LDS_CW_OFF);
    const int cp = unit & 3, tt = (unit >> 2) & 127, b = unit >> 9, t0 = tt * 64;
    { const int tl = tid >> 3, c8 = (tid & 7) * 8; const bf16_t* hy0 = HY + (size_t)b * SEQ * HYP;
      SC8 x1[2], vv[2];
#pragma unroll
      for (int r = 0; r < 2; ++r) { const int c0 = (cp * 2 + r) * 64; x1[r] = short_conv8(hy0, t0 + tl, SEQ, 512 + c0 + c8, cwl); vv[r] = short_conv8(hy0, t0 + tl, SEQ, 1024 + c0 + c8, cwl); }
#pragma unroll
      for (int r = 0; r < 2; ++r) { LAS float* T = (LAS float*)lds + r * 4160;
#pragma unroll
          for (int e = 0; e < 8; ++e) T[(c8 + e) * 65 + tl] = x1[r].v[e] * vv[r].v[e]; } }
    __syncthreads();
    { const int cl = tid >> 3, t8 = (tid & 7) * 8;
#pragma unroll
      for (int r = 0; r < 2; ++r) { const int c0 = (cp * 2 + r) * 64; bf16_t* o = VT + ((size_t)(c0 + cl) * NB + b) * SEQ + t0 + t8; const LAS float* sp = (const LAS float*)lds + r * 4160 + cl * 65 + t8;
          u32x4 w; w.x = pk2(sp[0], sp[1]); w.y = pk2(sp[2], sp[3]); w.z = pk2(sp[4], sp[5]); w.w = pk2(sp[6], sp[7]); *(u32x4*)o = w; } }
    __syncthreads();
}
__device__ __forceinline__ void hy_post_unit(const bf16_t* HY, const bf16_t* VT, bf16_t* HYO, const float* hb, int unit, LAS unsigned char* lds, int tid) {
    const LAS float* cwl = (const LAS float*)(lds + LDS_CW_OFF);
    LAS float* T = (LAS float*)lds;
    const int ct = unit & 7, tt = (unit >> 3) & 127, b = unit >> 10, t0 = tt * 64, c0 = ct * 64;
    { const int cl = tid >> 3, t8 = (tid & 7) * 8; const bf16_t* o = VT + ((size_t)(c0 + cl) * NB + b) * SEQ + t0 + t8; LAS float* s = T + cl * 65 + t8;
      const u32x4 a = *(const u32x4*)o; s[0] = bflo(a.x); s[1] = bfhi(a.x); s[2] = bflo(a.y); s[3] = bfhi(a.y); s[4] = bflo(a.z); s[5] = bfhi(a.z); s[6] = bflo(a.w); s[7] = bfhi(a.w); }
    __syncthreads();
    { const int tl = tid >> 3, c8 = (tid & 7) * 8; const bf16_t* hy0 = HY + (size_t)b * SEQ * HYP;
      const SC8 x0 = short_conv8(hy0, t0 + tl, SEQ, c0 + c8, cwl), x1 = short_conv8(hy0, t0 + tl, SEQ, 512 + c0 + c8, cwl), vv = short_conv8(hy0, t0 + tl, SEQ, 1024 + c0 + c8, cwl);
      float r[8]; const f32x4 hba = *(const f32x4*)(hb + c0 + c8), hbb = *(const f32x4*)(hb + c0 + c8 + 4);
#pragma unroll
      for (int e = 0; e < 8; ++e) { const float vx = x1.v[e] * vv.v[e]; r[e] = (T[(c8 + e) * 65 + tl] + vx * (e < 4 ? hba[e & 3] : hbb[e & 3])) * x0.v[e]; }
      u32x4 w; w.x = pk2(r[0], r[1]); w.y = pk2(r[2], r[3]); w.z = pk2(r[4], r[5]); w.w = pk2(r[6], r[7]);
      *(u32x4*)(HYO + ((size_t)b * SEQ + t0 + tl) * HYW + c0 + c8) = w; }
    __syncthreads();
}
__device__ __forceinline__ void hy_ctx_unit(const bf16_t* HY, const float* FC, bf16_t* HYO, const float* hb, int unit, LAS unsigned char* lds, int tid) {
    const LAS float* cwl = (const LAS float*)(lds + LDS_CW_OFF);
    LAS float* VX = (LAS float*)lds;
    const int ct = unit & 31, b = unit >> 5, c0 = ct * 16; const bf16_t* hy0 = HY + (size_t)(MLAT + b * CTXL) * HYP;
    { const int s = tid >> 1, c8 = (tid & 1) * 8; const SC8 x1 = short_conv8(hy0, s, CTXL, 512 + c0 + c8, cwl), vv = short_conv8(hy0, s, CTXL, 1024 + c0 + c8, cwl);
#pragma unroll
      for (int e = 0; e < 8; ++e) VX[s * 16 + c8 + e] = x1.v[e] * vv.v[e]; }
    __syncthreads();
    LAS float* KK = (LAS float*)lds + 4096;
    for (int e = tid; e < 511 * 16; e += 512) { const int n = (e >> 4) - 255, cc = e & 15; KK[e] = n >= 0 ? FC[(size_t)n * 1024 + c0 + cc] : FC[(size_t)(-n) * 1024 + 512 + c0 + cc]; }
    __syncthreads();
    { const int c = tid & 15, tg = tid >> 4, t0 = tg * 8;
      float acc[8];
#pragma unroll
      for (int j = 0; j < 8; ++j) acc[j] = 0.f;
      for (int s0 = 0; s0 < CTXL; s0 += 8) {
          float q[15], vx[8]; const LAS float* kq = KK + (t0 + 255 - s0 - 7) * 16 + c;
#pragma unroll
          for (int i = 0; i < 15; ++i) q[i] = kq[i * 16];
#pragma unroll
          for (int u = 0; u < 8; ++u) vx[u] = VX[(s0 + u) * 16 + c];
#pragma unroll
          for (int u = 0; u < 8; ++u)
#pragma unroll
              for (int j = 0; j < 8; ++j) acc[j] += q[7 - u + j] * vx[u];
      }
#pragma unroll
      for (int j = 0; j < 8; ++j) { const int t = t0 + j;
          const int col = c0 + c; const bf16_t* hr = hy0 + (size_t)t * HYP + col;
          const float um = t > 0 ? bflo((unsigned)hr[-HYP]) : 0.f, u0 = bflo((unsigned)hr[0]), up = t + 1 < CTXL ? bflo((unsigned)hr[HYP]) : 0.f;
          const float x0 = um * cwl[col] + u0 * cwl[HYP + col] + up * cwl[2 * HYP + col] + cwl[3 * HYP + col];
          HYO[((size_t)MLAT + b * CTXL + t) * HYW + col] = (bf16_t)f2bf((acc[j] + VX[t * 16 + c] * hb[col]) * x0);
      } }
    __syncthreads();
}
__device__ __forceinline__ f32x4 ld4row(const float* p) { return *(const f32x4*)p; }
__device__ __forceinline__ f32x4 ld4row(const bf16_t* p) { const u32x2 w = *(const u32x2*)p; return (f32x4){bflo(w.x), bfhi(w.x), bflo(w.y), bfhi(w.y)}; }
template <bool SRCBF> __device__ __forceinline__ const void* norm_row_ptr(const float* lat, const float* ctxp, const bf16_t* XS, int m) {
    if (SRCBF) return XS + (size_t)m * DM;
    return m < MLAT ? lat + (size_t)m * DM : ctxp + (size_t)(m - MLAT) * DM;
}
template <bool SRCBF> __device__ __forceinline__ void norm_row_load(const void* p, int lane, f32x4 (&v)[4]) {
#pragma unroll
    for (int j = 0; j < 4; ++j) v[j] = SRCBF ? ld4row((const bf16_t*)p + 4 * lane + 256 * j) : ld4row((const float*)p + 4 * lane + 256 * j);
}
template <bool SRCBF> __device__ __forceinline__ void norm_mod_rows(const float* lat, const float* ctxp, const bf16_t* XS, int nrows, const float* gain, const float* shift, const float* scale, bf16_t* H, int gw, int NGW, int lane) {
    const int rpw = (nrows + NGW - 1) / NGW, r0 = gw * rpw, r1 = (r0 + rpw < nrows) ? r0 + rpw : nrows;
    int cb = -1; f32x4 gm[4], shv[4];
    for (int m0 = r0; m0 < r1; m0 += 2) {
        const int m1 = m0 + 1; const bool has1 = m1 < r1; const int m1c = has1 ? m1 : m0;
        f32x4 v0[4], v1[4];
        if (SRCBF) {
#pragma unroll
            for (int j = 0; j < 4; ++j) { v0[j] = ld4row(XS + (size_t)m0 * DM + 4 * lane + 256 * j); v1[j] = ld4row(XS + (size_t)m1c * DM + 4 * lane + 256 * j); }
        } else {
            const float* src0 = m0 < MLAT ? lat + (size_t)m0 * DM : ctxp + (size_t)(m0 - MLAT) * DM; const float* src1 = m1c < MLAT ? lat + (size_t)m1c * DM : ctxp + (size_t)(m1c - MLAT) * DM;
#pragma unroll
            for (int j = 0; j < 4; ++j) { v0[j] = ld4row(src0 + 4 * lane + 256 * j); v1[j] = ld4row(src1 + 4 * lane + 256 * j); }
        }
#pragma unroll
        for (int r = 0; r < 2; ++r) {
            if (r == 1 && !has1) break;
            const int m = r ? m1 : m0; const int bidx = m < MLAT ? (m >> 13) : 8;
            if (bidx != cb) { cb = bidx;
#pragma unroll
                for (int j = 0; j < 4; ++j) { const int col = 4 * lane + 256 * j; gm[j] = *(const f32x4*)(gain + col) * (*(const f32x4*)(scale + (size_t)bidx * NMODV + col) + 1.f); shv[j] = *(const f32x4*)(shift + (size_t)bidx * NMODV + col); } }
            float ss = 0.f;
#pragma unroll
            for (int j = 0; j < 4; ++j) { const f32x4 v = r ? v1[j] : v0[j]; ss += (v[0] * v[0] + v[1] * v[1]) + (v[2] * v[2] + v[3] * v[3]); }
            const float rstd = __builtin_amdgcn_rsqf(wave_sum(ss, lane) * (1.f / DM) + EPS);
#pragma unroll
            for (int j = 0; j < 4; ++j) { const f32x4 v = r ? v1[j] : v0[j]; const int col = 4 * lane + 256 * j;
                const f32x4 y = v * rstd * gm[j] + shv[j]; u32x2 w; w.x = pk2(y[0], y[1]); w.y = pk2(y[2], y[3]); *(u32x2*)(H + (size_t)m * DM + col) = w; }
        }
    }
}
__device__ __forceinline__ void final_norm_rows(const bf16_t* XS, float* X, const float* gain, int gw, int NGW, int lane) {
    const int rpw = (MLAT + NGW - 1) / NGW, r0 = gw * rpw, r1 = (r0 + rpw < MLAT) ? r0 + rpw : MLAT;
    f32x4 gv[4];
#pragma unroll
    for (int j = 0; j < 4; ++j) gv[j] = *(const f32x4*)(gain + 4 * lane + 256 * j);
    for (int m0 = r0; m0 < r1; m0 += 2) {
        const int m1 = m0 + 1; const bool has1 = m1 < r1; const int m1c = has1 ? m1 : m0;
        f32x4 v0[4], v1[4];
#pragma unroll
        for (int j = 0; j < 4; ++j) { v0[j] = ld4row(XS + (size_t)m0 * DM + 4 * lane + 256 * j); v1[j] = ld4row(XS + (size_t)m1c * DM + 4 * lane + 256 * j); }
#pragma unroll
        for (int r = 0; r < 2; ++r) {
            if (r == 1 && !has1) break;
            float* dst = X + (size_t)(r ? m1 : m0) * DM; float ss = 0.f;
#pragma unroll
            for (int j = 0; j < 4; ++j) { const f32x4 v = r ? v1[j] : v0[j]; ss += (v[0] * v[0] + v[1] * v[1]) + (v[2] * v[2] + v[3] * v[3]); }
            const float rstd = __builtin_amdgcn_rsqf(wave_sum(ss, lane) * (1.f / DM) + EPS);
#pragma unroll
            for (int j = 0; j < 4; ++j) { const f32x4 v = r ? v1[j] : v0[j]; *(f32x4*)(dst + 4 * lane + 256 * j) = v * rstd * gv[j]; }
        }
    }
}
__device__ __forceinline__ bf16_t* qk_item_ptr(bf16_t* Q, bf16_t* Kp, long it, int l16, int& m, int& hr) {
    m = (int)(it >> 1); hr = 8 + (int)(it & 1);
    const size_t krow = m < MLAT ? (size_t)(m >> 13) * KEYS + CTXL + (m & 8191) : (size_t)((m - MLAT) >> 8) * KEYS + ((m - MLAT) & 255);
    return Kp + krow * 256 + (hr - 8) * 128 + l16 * 8;
}
__device__ __forceinline__ void qk_rows(bf16_t* Q, bf16_t* Kp, const float* qg, const float* kg, const f32x2* rope, int gw, int NGW, int lane) {
    const int l16 = lane & 15, sub = lane >> 4; const long total = (long)MALL * 2, step = (long)NGW * 4;
    const f32x4 kga = *(const f32x4*)(kg + l16 * 8), kgb = *(const f32x4*)(kg + l16 * 8 + 4); (void)qg;
    for (long it0 = (long)gw * 4 + sub; it0 < total; it0 += 4 * step) {
        bf16_t* ptr[4]; int mm[4], hh[4]; u32x4 w[4];
#pragma unroll
        for (int r = 0; r < 4; ++r) { const long it = it0 + r * step; const long itc = it < total ? it : it0; ptr[r] = qk_item_ptr(Q, Kp, itc, l16, mm[r], hh[r]); w[r] = *(const u32x4*)ptr[r]; }
#pragma unroll
        for (int r = 0; r < 4; ++r) {
            const bool valid = (it0 + r * step) < total;
            const int m = mm[r]; const bool lat = m < MLAT;
            float v[8];
#pragma unroll
            for (int e = 0; e < 4; ++e) { v[2 * e] = bflo(w[r][e]); v[2 * e + 1] = bfhi(w[r][e]); }
            float ss = 0.f;
#pragma unroll
            for (int e = 0; e < 8; ++e) ss += v[e] * v[e];
            ss += shx(ss, 1, lane); ss += shx(ss, 2, lane); ss += shx(ss, 4, lane); ss += shx(ss, 8, lane);
            const float rstd = __builtin_amdgcn_rsqf(ss * (1.f / 128.f) + EPS);
#pragma unroll
            for (int e = 0; e < 8; ++e) v[e] = v[e] * rstd * (e < 4 ? kga[e & 3] : kgb[e & 3]);
            if (lat) { const f32x2* rp = rope + (size_t)(m & 8191) * 64 + l16 * 4;
#pragma unroll
                for (int e = 0; e < 4; ++e) { const f32x2 cs = rp[e]; const float a = v[2 * e], b = v[2 * e + 1]; v[2 * e] = a * cs.x - b * cs.y; v[2 * e + 1] = a * cs.y + b * cs.x; } }
            u32x4 o; o.x = pk2(v[0], v[1]); o.y = pk2(v[2], v[3]); o.z = pk2(v[4], v[5]); o.w = pk2(v[6], v[7]);
            if (valid) *(u32x4*)ptr[r] = o;
        }
    }
}
#define GEMM_RUN(EPI, Aptr, Btptr, Mrows, Ncols, Kdim, Eobj) do { pg8::Gemm g_{(const pg8::bf16_t*)(Aptr), (const pg8::bf16_t*)(Btptr), (Mrows), (Ncols), (Kdim)}; pg8::StaticOrder S_; S_.init((Mrows), (Ncols), G, bid); \
    pg8::gemm_phase<EPI, pg8::StaticOrder, true, true>(lds, g_, S_, (Eobj), tid); } while (0)

__device__ __forceinline__ Params kparams() {
#if defined(__HIP_DEVICE_COMPILE__)
    auto q = __builtin_amdgcn_kernarg_segment_ptr(); asm volatile("" : "+s"(q)); return *(const __attribute__((address_space(4))) Params*)q;
#else
    return Params{};
#endif
}
#define PH_BEGIN() const Params p = kparams(); unsigned char* ws = p.ws; (void)ws
__global__ void __launch_bounds__(512, 2) fwd_megakernel(Params p_unused) {
    extern __shared__ __attribute__((aligned(16))) unsigned char smem[];
    cg::grid_group grid = cg::this_grid();
    LAS unsigned char* lds = (LAS unsigned char*)smem;
    const int wave0 = __builtin_amdgcn_readfirstlane((int)threadIdx.x >> 6);
    unsigned xcc_id;
    { const int t0_ = (wave0 << 6) | lane_fresh();
      if (t0_ < 2) ((volatile LAS unsigned*)(lds + LDS_CTL_OFF))[t0_] = 0u;
      for (int k = t0_; k < 2048; k += 512) { float sn, cs; sincospif((float)k * (1.f / 8192.f), &sn, &cs); ((LAS f32x2*)(lds + LDS_TW_OFF))[k] = (f32x2){cs, -sn}; }
      __syncthreads();
      XcdBarrier xb0 = xcd_barrier_post((unsigned*)(kparams().ws + WS_BAR), (volatile LAS unsigned*)(lds + LDS_CTL_OFF), t0_); xcc_id = xb0.x; }
#define GRID_BAR() do { XcdBarrier b_; b_.tid = (wave0 << 6) | lane_fresh(); b_.bar = (unsigned*)(kparams().ws + WS_BAR); b_.x = xcc_id; b_.st = (volatile LAS unsigned*)(lds + LDS_CTL_OFF); xcd_barrier(b_); } while (0)
#define TID_VARS() const int lane = lane_fresh(), tid = (wave0 << 6) | lane, wave = wave0; int G = gridDim.x, bid = blockIdx.x; asm volatile("" : "+s"(G), "+s"(bid)); const int gw = bid * 8 + wave, NGW = G * 8; (void)lane; (void)gw; (void)NGW
    { PH_BEGIN(); TID_VARS();
      phase_weights(p, lds, gw, NGW, wave, lane);
      __syncthreads(); }
    { PH_BEGIN(); TID_VARS();
      for (int u = bid; u < 192; u += G) mod_unit(p, u, lds, tid); }
    { PH_BEGIN(); TID_VARS(); float* filtT = (float*)(ws + WS_FILT); float* filtC = (float*)(ws + WS_FILTC);
      int staged = -1;
      for (int u = bid; u < 2 * 512 + 16; u += G) {
        { const int lf = (u < 1024) ? (u >> 9) : 0; if (lf != staged) { filter_stage_weights(p, lf, lds, tid); staged = lf; } }
        if (u < 1024) filter_unit(p, u >> 9, SEQ, (u & 511) * 16, filtT + (size_t)(u >> 9) * 1024 * SEQ, true, lds, tid);
        else filter_unit(p, 0, CTXL, (u - 1024) * 16, filtC, false, lds, tid);
      } }
    { PH_BEGIN(); TID_VARS(); f32x2* rope = (f32x2*)(ws + WS_ROPE);
      for (int e = bid * 512 + tid; e < SEQ * 64; e += G * 512) { const int t = e >> 6, i = e & 63; const float pos = (float)(i < 32 ? (t >> 6) : (t & 63));
        const float inv = powf(10000.f, -(float)(2 * (i & 31)) * (1.f / 64.f)); float s, c; sincosf(pos * inv, &s, &c); rope[e] = (f32x2){c, s}; } }
    grid.sync();
    if (((wave0 << 6) | lane_fresh()) == 0) { unsigned nloc, nx; xcd_barrier_complete((unsigned*)(kparams().ws + WS_BAR), xcc_id, nloc, nx); ((volatile LAS unsigned*)(lds + LDS_CTL_OFF))[0] = nloc; ((volatile LAS unsigned*)(lds + LDS_CTL_OFF))[1] = nx; }
    __syncthreads();

    for (int l = 0; l < DEPTH; ++l) {
        asm volatile("" : "+s"(l));
        { PH_BEGIN(); TID_VARS(); const float* modl = (const float*)(ws + WS_MOD) + (size_t)l * 9 * NMODV;
          if (l == 0) for (int c = bid; c < HYW; c += G) kf_unit((const float*)(ws + WS_FILT) + (size_t)l * 1024 * SEQ, (f32x2*)(ws + WS_KF), c, lds, tid);
          if (l == 0) norm_mod_rows<false>(p.x, p.ctx, nullptr, MALL, p.norm_mix + l * DM, modl + 0 * DM, modl + 1 * DM, (bf16_t*)(ws + WS_H), gw, NGW, lane);
          else norm_mod_rows<true>(nullptr, nullptr, (const bf16_t*)(ws + WS_XS), MALL, p.norm_mix + l * DM, modl + 0 * DM, modl + 1 * DM, (bf16_t*)(ws + WS_H), gw, NGW, lane); }
        GRID_BAR();
        { PH_BEGIN(); TID_VARS(); const unsigned char* wb = ws + WS_W + (size_t)l * WL_STRIDE;
          pg8::EpiIn E{(bf16_t*)(ws + WS_Q), (bf16_t*)(ws + WS_K), (bf16_t*)(ws + WS_V), (bf16_t*)(ws + WS_HY), (bf16_t*)p.out, (bf16_t*)(ws + WS_G)}; GEMM_RUN(pg8::EpiIn, ws + WS_H, wb + WL_IN, MALL, PROJ, DM, E); }
        GRID_BAR();
        { PH_BEGIN(); TID_VARS();
          qk_rows((bf16_t*)(ws + WS_Q), (bf16_t*)(ws + WS_K), p.q_norm + l * 128, p.k_norm + l * 128, (const f32x2*)(ws + WS_ROPE), gw, NGW, lane);
          stage_conv_weights(p.conv_w + (size_t)l * 3 * HYP, p.conv_b + (size_t)l * HYP, lds, tid);
          for (int u = bid; u < NB * 128 * 4; u += G) hy_pre_unit((const bf16_t*)(ws + WS_HY), (bf16_t*)(ws + WS_H), u, lds, tid); }
        GRID_BAR();
        { PH_BEGIN(); TID_VARS();
          const attn::bf16* Qa = (const attn::bf16*)(ws + WS_Q); const attn::bf16* Ka = (const attn::bf16*)(ws + WS_K); const attn::bf16* Va = (const attn::bf16*)(ws + WS_V);
          for (int i = 0; bid + i * G < 2048; ++i) {
            int u = bid + i * G;
            if (G == 256) { const int xcd = bid & 7, j = bid >> 3; u = ((xcd * 2 + (i >> 2)) << 7) + ((i & 3) << 5) + j; }
            const int qb = u & 31, g4 = (u >> 5) & 3, kvh = (u >> 7) & 1, b = u >> 8, h = kvh * 4 + g4;
            const attn::bf16* Qp = Qa + ((size_t)b * SEQ + qb * 256) * DM + h * 128;
            attn::attn_dense_body<attn::bf16>(Qp, Ka + (size_t)b * KEYS * 256 + kvh * 128, Va + (size_t)b * KEYS * 256 + kvh * 128, (attn::bf16*)Qp, KEYS, (char*)smem, (wave0 << 6) | lane_fresh(), p.q_norm + l * 128, (const f32x2*)(ws + WS_ROPE) + (size_t)qb * 256 * 64);
            __syncthreads();
          }
          if (l == 0) for (int u = bid; u < 64; u += G) {
            const int h = u & 7, b = u >> 3, kvh = h >> 2;
            const attn::bf16* Qp = Qa + ((size_t)MLAT + b * CTXL) * DM + h * 128;
            attn::attn_dense_body<attn::bf16>(Qp, Ka + (size_t)b * KEYS * 256 + kvh * 128, Va + (size_t)b * KEYS * 256 + kvh * 128, (attn::bf16*)Qp, CTXL, (char*)smem, (wave0 << 6) | lane_fresh(), p.q_norm + l * 128, (const f32x2*)nullptr);
            __syncthreads();
          } }
        { PH_BEGIN(); TID_VARS();
          fftconv_units((bf16_t*)(ws + WS_H), (const f32x2*)(ws + WS_KF), HYW * 4, bid, G, lds, tid); }
        GRID_BAR();
        { PH_BEGIN(); TID_VARS();
          stage_conv_weights(p.conv_w + (size_t)l * 3 * HYP, p.conv_b + (size_t)l * HYP, lds, tid);
          for (int u = bid; u < NB * 128 * 8; u += G) hy_post_unit((const bf16_t*)(ws + WS_HY), (const bf16_t*)(ws + WS_H), (bf16_t*)(ws + WS_HYO), p.hbias + (size_t)l * HYW, u, lds, tid);
          if (l == 0) for (int u = bid; u < 256; u += G) hy_ctx_unit((const bf16_t*)(ws + WS_HY), (const float*)(ws + WS_FILTC), (bf16_t*)(ws + WS_HYO), p.hbias + (size_t)l * HYW, u, lds, tid); }
        GRID_BAR();
        { PH_BEGIN(); TID_VARS(); const unsigned char* wb = ws + WS_W + (size_t)l * WL_STRIDE; const int Mmix = (l == DEPTH - 1) ? MLAT : MALL;
          pg8::EpiMerge<false> E{(const bf16_t*)p.out, (const bf16_t*)(ws + WS_G), (bf16_t*)(ws + WS_HY), 0}; GEMM_RUN(pg8::EpiMerge<false>, ws + WS_Q, wb + WL_OA, Mmix, DM, DM, E); }
        { PH_BEGIN(); TID_VARS(); const unsigned char* wb = ws + WS_W + (size_t)l * WL_STRIDE; const int Mmix = (l == DEPTH - 1) ? MLAT : MALL;
          pg8::EpiMerge<true> E{(const bf16_t*)p.out, (const bf16_t*)(ws + WS_G), (bf16_t*)(ws + WS_HY), DM}; GEMM_RUN(pg8::EpiMerge<true>, ws + WS_HYO, wb + WL_OH, Mmix, DM, HYW, E); }
        GRID_BAR();
        { PH_BEGIN(); TID_VARS(); const unsigned char* wb = ws + WS_W + (size_t)l * WL_STRIDE; const int Mmix = (l == DEPTH - 1) ? MLAT : MALL; const float* modl = (const float*)(ws + WS_MOD) + (size_t)l * 9 * NMODV;
          if (l == 0) { pg8::EpiResid<true> E{p.x, p.ctx, (bf16_t*)(ws + WS_XS), modl + 2 * DM}; GEMM_RUN(pg8::EpiResid<true>, ws + WS_HY, wb + WL_OUT, Mmix, DM, DM, E); }
          else { pg8::EpiResid<false> E{nullptr, nullptr, (bf16_t*)(ws + WS_XS), modl + 2 * DM}; GEMM_RUN(pg8::EpiResid<false>, ws + WS_HY, wb + WL_OUT, Mmix, DM, DM, E); } }
        GRID_BAR();
        { PH_BEGIN(); TID_VARS(); const int Mmix = (l == DEPTH - 1) ? MLAT : MALL; const float* modl = (const float*)(ws + WS_MOD) + (size_t)l * 9 * NMODV;
          norm_mod_rows<true>(nullptr, nullptr, (const bf16_t*)(ws + WS_XS), Mmix, p.norm_ffn + l * DM, modl + 3 * DM, modl + 4 * DM, (bf16_t*)(ws + WS_H), gw, NGW, lane); }
        GRID_BAR();
        { PH_BEGIN(); TID_VARS(); const unsigned char* wb = ws + WS_W + (size_t)l * WL_STRIDE; const int Mmix = (l == DEPTH - 1) ? MLAT : MALL;
          pg8::EpiSwiglu E{(bf16_t*)(ws + WS_ACT)}; GEMM_RUN(pg8::EpiSwiglu, ws + WS_H, wb + WL_GU, Mmix, 2 * DFF, DM, E); }
        GRID_BAR();
        { PH_BEGIN(); TID_VARS(); const unsigned char* wb = ws + WS_W + (size_t)l * WL_STRIDE; const int Mmix = (l == DEPTH - 1) ? MLAT : MALL; const float* modl = (const float*)(ws + WS_MOD) + (size_t)l * 9 * NMODV;
          pg8::EpiResid<false> E{nullptr, nullptr, (bf16_t*)(ws + WS_XS), modl + 5 * DM}; GEMM_RUN(pg8::EpiResid<false>, ws + WS_ACT, wb + WL_DN, Mmix, DM, DFF, E);
          if (l == 0) { const int nwg = (MALL / 256) * (DM / 256), first = (nwg % G) ? nwg % G : 0;
            if (bid >= first) { __syncthreads(); for (int c = bid - first; c < HYW; c += G - first) kf_unit((const float*)(ws + WS_FILT) + (size_t)1024 * SEQ, (f32x2*)(ws + WS_KF), c, lds, tid); } } }
        GRID_BAR();
    }
    { PH_BEGIN(); TID_VARS();
      final_norm_rows((const bf16_t*)(ws + WS_XS), p.out, p.norm_final, gw, NGW, lane); }
}

extern "C" void kernel_launch(void* const* d_in, const int* in_sizes, int n_in, void* d_out, int out_size, void* d_ws, size_t ws_size, hipStream_t stream) {
    static int grid_blocks = 0;
    if (grid_blocks == 0) {
        if (n_in != 28 || in_sizes[0] != MLAT * DM || out_size != MLAT * DM || ws_size < WS_END) {
            fprintf(stderr, "kernel_launch: shape/workspace mismatch: n_in %d in0 %d out %d ws %zu (need >= %zu)\n", n_in, n_in > 0 ? in_sizes[0] : -1, out_size, ws_size, (size_t)WS_END); grid_blocks = -1; return; }
        int dev = 0, cus = 0, per_cu = 0;
        hipGetDevice(&dev); hipDeviceGetAttribute(&cus, hipDeviceAttributeMultiprocessorCount, dev);
        if (hipFuncSetAttribute((const void*)fwd_megakernel, hipFuncAttributeMaxDynamicSharedMemorySize, LDS_BYTES) != hipSuccess) { fprintf(stderr, "kernel_launch: hipFuncSetAttribute failed\n"); grid_blocks = -1; return; }
        if (hipOccupancyMaxActiveBlocksPerMultiprocessor(&per_cu, (const void*)fwd_megakernel, 512, LDS_BYTES) != hipSuccess || per_cu < 1) { fprintf(stderr, "kernel_launch: occupancy query says %d\n", per_cu); per_cu = 1; }
        (void)hipGetLastError();
        grid_blocks = cus * 1;
    }
    if (grid_blocks < 0) return;
    if (hipMemsetAsync((char*)d_ws + WS_BAR, 0, WS_BAR_BYTES, stream) != hipSuccess) { fprintf(stderr, "kernel_launch: memset of barrier words failed\n"); return; }
    Params p{};
    const float** pp = (const float**)&p;
    for (int i = 0; i < 28; ++i) pp[i] = (const float*)d_in[i];
    p.out = (float*)d_out; p.ws = (unsigned char*)d_ws;
    void* args[] = {&p};
    hipError_t e = hipLaunchCooperativeKernel((const void*)fwd_megakernel, dim3(grid_blocks), dim3(512), args, LDS_BYTES, stream);
    if (e != hipSuccess) fprintf(stderr, "cooperative launch failed: %s (grid %d)\n", hipGetErrorString(e), grid_blocks);
}
```
